# Optimizing an MI355X kernel written in HIP

```python
import math
import numpy as np
import jax
import jax.numpy as jnp
from jax import lax

D_MODEL = 1024
BATCH = 4
SEQ = 4096
DEPTH = 4

HEAD_DIM = 64
ROPE_THETA = 10000.0
NORM_EPS = 1e-6
D_FF = 4 * D_MODEL
Q_BLOCK = 128

A_HEADS = D_MODEL // (2 * HEAD_DIM)
IDX_HEADS = 4
DSA_TOPK = 256

B_HEADS = D_MODEL // (2 * HEAD_DIM)
B_KV_GROUPS = 2
CMP_BLOCK = 32
CMP_STRIDE = 16
CMP_HIDDEN = 256
SLC_BLOCK = 64
SLC_TOPN = 16
WINDOW = 512

C_HEADS = D_MODEL // (2 * HEAD_DIM)

EVEN_SPLITS = (A_HEADS * HEAD_DIM, HEAD_DIM, HEAD_DIM, IDX_HEADS * HEAD_DIM, HEAD_DIM, IDX_HEADS, B_HEADS * HEAD_DIM, 6 * B_KV_GROUPS * HEAD_DIM, 3 * B_HEADS)
EVEN_IN = sum(EVEN_SPLITS)
EVEN_MIX = (A_HEADS + B_HEADS) * HEAD_DIM
ODD_MIX = C_HEADS * 2 * HEAD_DIM
ODD_IN = 3 * ODD_MIX

kernel_name = 'hybrid_dsa_nsa_diffattn_trunk'


def rms_norm(x, g):
    xf = x.astype(jnp.float32)
    y = xf * lax.rsqrt(jnp.mean(xf * xf, axis=-1, keepdims=True) + NORM_EPS)
    return (y * g.astype(jnp.float32)).astype(x.dtype)


def rope_tables(T):
    inv = 1.0 / (ROPE_THETA ** (jnp.arange(0, HEAD_DIM, 2, dtype=jnp.float32) / HEAD_DIM))
    ang = jnp.arange(T, dtype=jnp.float32)[:, None] * inv[None, :]
    return jnp.cos(ang), jnp.sin(ang)


def apply_rope(x, cos, sin):
    x1, x2 = jnp.split(x, 2, axis=-1)
    shape = (1, cos.shape[0]) + (1,) * (x.ndim - 3) + (cos.shape[1],)
    c = cos.reshape(shape).astype(x.dtype)
    s = sin.reshape(shape).astype(x.dtype)
    return jnp.concatenate([x1 * c - x2 * s, x2 * c + x1 * s], axis=-1)


def masked_softmax(s, mask):
    s = jnp.where(mask, s.astype(jnp.float32), -jnp.inf)
    m = jnp.max(s, axis=-1, keepdims=True)
    m = jnp.where(jnp.isfinite(m), m, 0.0)
    e = jnp.exp(s - m)
    return e / jnp.maximum(jnp.sum(e, axis=-1, keepdims=True), 1e-30)


def split_cols(a, sizes):
    offs = np.cumsum(sizes)[:-1].tolist()
    return jnp.split(a, offs, axis=-1)


def sweep_query_blocks(fn, T):
    nb = T // Q_BLOCK
    out = lax.map(fn, jnp.arange(nb))
    out = jnp.moveaxis(out, 0, 1)
    return out.reshape((out.shape[0], T) + out.shape[3:])


def dsa_attention(q, k, v, q_idx, k_idx, w_idx):
    T = q.shape[1]
    topk = min(DSA_TOPK, T // 4)
    scale = HEAD_DIM ** -0.5
    key_pos = jnp.arange(T)

    def block(i):
        t0 = i * Q_BLOCK
        tq = t0 + jnp.arange(Q_BLOCK)
        qb = lax.dynamic_slice_in_dim(q, t0, Q_BLOCK, 1)
        qib = lax.dynamic_slice_in_dim(q_idx, t0, Q_BLOCK, 1)
        wb = lax.dynamic_slice_in_dim(w_idx, t0, Q_BLOCK, 1)
        rel = jax.nn.relu(jnp.einsum('bqhd,bsd->bqhs', qib, k_idx).astype(jnp.float32))
        score = jnp.einsum('bqh,bqhs->bqs', wb.astype(jnp.float32), rel)
        score = jnp.where(key_pos[None, :] <= tq[:, None], score, -jnp.inf)
        _, idx = lax.top_k(score, topk)
        valid = idx <= tq[None, :, None]
        kg = jax.vmap(lambda kk, ii: kk[ii])(k, idx)
        vg = jax.vmap(lambda vv, ii: vv[ii])(v, idx)
        s = jnp.einsum('bqhd,bqkd->bhqk', qb, kg) * scale
        p = masked_softmax(s, valid[:, None])
        return jnp.einsum('bhqk,bqkd->bqhd', p.astype(vg.dtype), vg)

    return sweep_query_blocks(block, T)


def compress_blocks(x, pe, w1, w2):
    bsz, T, G, D = x.shape
    n_ch = T // CMP_STRIDE
    r = CMP_BLOCK // CMP_STRIDE
    n_c = n_ch - r + 1
    ch = x.reshape(bsz, n_ch, CMP_STRIDE, G, D)
    blk = jnp.concatenate([ch[:, j:j + n_c] for j in range(r)], axis=2)
    blk = blk + pe[None, None, :, None, :].astype(x.dtype)
    h = jax.nn.gelu(jnp.einsum('bnlgd,ldf->bngf', blk, w1.reshape(CMP_BLOCK, D, CMP_HIDDEN)))
    return jnp.einsum('bngf,fd->bngd', h, w2)


def slc_overlap(n_c, n_s):
    c0 = np.arange(n_c) * CMP_STRIDE
    c1 = c0 + CMP_BLOCK
    s0 = np.arange(n_s) * SLC_BLOCK
    s1 = s0 + SLC_BLOCK
    return ((c0[:, None] < s1[None, :]) & (c1[:, None] > s0[None, :])).astype(np.float32)


def nsa_attention(q, k_c, v_c, k_s, v_s, k_w, v_w, gate_logits, cmp_pe, cmp_w1, cmp_w2):
    bsz, T = q.shape[0], q.shape[1]
    G, J, D = B_KV_GROUPS, B_HEADS // B_KV_GROUPS, HEAD_DIM
    scale = D ** -0.5
    qg = q.reshape(bsz, T, G, J, D)
    g = jax.nn.sigmoid(gate_logits.astype(jnp.float32)).astype(q.dtype).reshape(bsz, T, G, J, 3)
    t_all = jnp.arange(T)

    kc = compress_blocks(k_c, cmp_pe[0], cmp_w1[0], cmp_w2[0])
    vc = compress_blocks(v_c, cmp_pe[1], cmp_w1[1], cmp_w2[1])
    n_c = kc.shape[1]
    cmp_end = jnp.arange(n_c) * CMP_STRIDE + CMP_BLOCK - 1
    s_c = jnp.einsum('btgjd,bngd->bgjtn', qg, kc) * scale
    p_c = masked_softmax(s_c, cmp_end[None, :] <= t_all[:, None])
    o_c = jnp.einsum('bgjtn,bngd->btgjd', p_c.astype(vc.dtype), vc)

    n_s = T // SLC_BLOCK
    n_sel = min(SLC_TOPN, n_s)
    imp = jnp.einsum('bgjtn,nm->bgtm', p_c, jnp.asarray(slc_overlap(n_c, n_s)))
    ks_blk = k_s.reshape(bsz, n_s, SLC_BLOCK, G, D).transpose(0, 3, 1, 2, 4)
    vs_blk = v_s.reshape(bsz, n_s, SLC_BLOCK, G, D).transpose(0, 3, 1, 2, 4)
    kw_pad = jnp.pad(k_w, ((0, 0), (WINDOW, 0), (0, 0), (0, 0)))
    vw_pad = jnp.pad(v_w, ((0, 0), (WINDOW, 0), (0, 0), (0, 0)))
    b_ix = jnp.arange(bsz)[:, None, None, None]
    g_ix = jnp.arange(G)[None, :, None, None]
    blk_ids = jnp.arange(n_s)

    def block(i):
        t0 = i * Q_BLOCK
        tq = t0 + jnp.arange(Q_BLOCK)
        qb = lax.dynamic_slice_in_dim(qg, t0, Q_BLOCK, 1)
        gq = lax.dynamic_slice_in_dim(g, t0, Q_BLOCK, 1)
        sc = lax.dynamic_slice_in_dim(imp, t0, Q_BLOCK, 2)
        cur = tq // SLC_BLOCK
        forced = (blk_ids[None, :] == 0) | (blk_ids[None, :] == cur[:, None]) | (blk_ids[None, :] == cur[:, None] - 1)
        admissible = blk_ids[None, :] * SLC_BLOCK <= tq[:, None]
        sc = jnp.where(forced, jnp.inf, sc)
        sc = jnp.where(admissible, sc, -jnp.inf)
        _, idx = lax.top_k(sc, n_sel)
        kg = ks_blk[b_ix, g_ix, idx]
        vg = vs_blk[b_ix, g_ix, idx]
        pos = idx[..., None] * SLC_BLOCK + jnp.arange(SLC_BLOCK)
        valid = (pos <= tq[None, None, :, None, None]).reshape(bsz, G, Q_BLOCK, n_sel * SLC_BLOCK)[:, :, None]
        s_s = jnp.einsum('bqgjd,bgqnsd->bgjqns', qb, kg).reshape(bsz, G, J, Q_BLOCK, n_sel * SLC_BLOCK) * scale
        p_s = masked_softmax(s_s, valid)
        o_s = jnp.einsum('bgjqk,bgqkd->bqgjd', p_s.astype(vg.dtype), vg.reshape(bsz, G, Q_BLOCK, n_sel * SLC_BLOCK, D))
        kw = lax.dynamic_slice_in_dim(kw_pad, t0, WINDOW + Q_BLOCK, 1)
        vw = lax.dynamic_slice_in_dim(vw_pad, t0, WINDOW + Q_BLOCK, 1)
        pos_w = t0 - WINDOW + jnp.arange(WINDOW + Q_BLOCK)
        valid_w = (pos_w[None, :] >= 0) & (pos_w[None, :] <= tq[:, None]) & (pos_w[None, :] > tq[:, None] - WINDOW)
        s_w = jnp.einsum('bqgjd,bsgd->bgjqs', qb, kw) * scale
        p_w = masked_softmax(s_w, valid_w)
        o_w = jnp.einsum('bgjqs,bsgd->bqgjd', p_w.astype(vw.dtype), vw)
        return gq[..., 1:2] * o_s + gq[..., 2:3] * o_w

    o_sw = sweep_query_blocks(block, T)
    o = g[..., 0:1] * o_c + o_sw
    return o.reshape(bsz, T, B_HEADS, D)


def even_mixer(h, w_in, cmp_pe, cmp_w1, cmp_w2, w_out, cos, sin):
    bsz, T, _ = h.shape
    proj = jnp.einsum('btd,de->bte', h, w_in)
    qa, ka, va, qi, ki, wi, qb, kvb, gb = split_cols(proj, EVEN_SPLITS)
    qa = apply_rope(qa.reshape(bsz, T, A_HEADS, HEAD_DIM), cos, sin)
    ka = apply_rope(ka, cos, sin)
    qi = apply_rope(qi.reshape(bsz, T, IDX_HEADS, HEAD_DIM), cos, sin)
    ki = apply_rope(ki, cos, sin)
    o_a = dsa_attention(qa, ka, va, qi, ki, wi)
    qb = apply_rope(qb.reshape(bsz, T, B_HEADS, HEAD_DIM), cos, sin)
    kvb = kvb.reshape(bsz, T, 6, B_KV_GROUPS, HEAD_DIM)
    k_c = apply_rope(kvb[:, :, 0], cos, sin)
    v_c = kvb[:, :, 1]
    k_s = apply_rope(kvb[:, :, 2], cos, sin)
    v_s = kvb[:, :, 3]
    k_w = apply_rope(kvb[:, :, 4], cos, sin)
    v_w = kvb[:, :, 5]
    o_b = nsa_attention(qb, k_c, v_c, k_s, v_s, k_w, v_w, gb, cmp_pe, cmp_w1, cmp_w2)
    o = jnp.concatenate([o_a.reshape(bsz, T, -1), o_b.reshape(bsz, T, -1)], axis=-1)
    return jnp.einsum('bte,ed->btd', o, w_out)


def diff_mixer(h, w_in, lam, subln_g, w_out, cos, sin, lambda_init):
    bsz, T, _ = h.shape
    proj = jnp.einsum('btd,de->bte', h, w_in)
    q, k, v = jnp.split(proj, 3, axis=-1)
    q = apply_rope(q.reshape(bsz, T, C_HEADS * 2, HEAD_DIM), cos, sin).reshape(bsz, T, C_HEADS, 2, HEAD_DIM)
    k = apply_rope(k.reshape(bsz, T, C_HEADS * 2, HEAD_DIM), cos, sin).reshape(bsz, T, C_HEADS, 2, HEAD_DIM)
    v = v.reshape(bsz, T, C_HEADS, 2 * HEAD_DIM)
    lf = lam.astype(jnp.float32)
    lam_val = jnp.exp(jnp.sum(lf[0] * lf[1])) - jnp.exp(jnp.sum(lf[2] * lf[3])) + lambda_init
    scale = HEAD_DIM ** -0.5
    key_pos = jnp.arange(T)

    def block(i):
        t0 = i * Q_BLOCK
        tq = t0 + jnp.arange(Q_BLOCK)
        qb = lax.dynamic_slice_in_dim(q, t0, Q_BLOCK, 1)
        s = jnp.einsum('bqhcd,bshcd->bhcqs', qb, k) * scale
        p = masked_softmax(s, key_pos[None, :] <= tq[:, None])
        a = p[:, :, 0] - lam_val * p[:, :, 1]
        return jnp.einsum('bhqs,bshe->bqhe', a.astype(v.dtype), v)

    o = sweep_query_blocks(block, T)
    o = rms_norm(o, subln_g) * (1.0 - lambda_init)
    return jnp.einsum('bte,ed->btd', o.reshape(bsz, T, ODD_MIX), w_out)


def sq_relu_mlp(h, w_up, w_down):
    u = jnp.einsum('btd,df->btf', h, w_up)
    return jnp.einsum('btf,fd->btd', jnp.square(jax.nn.relu(u)), w_down)


def setup_inputs(seed: int = 0) -> dict:
    key = jax.random.key(seed)
    ks = jax.random.split(key, 16)
    ne = (DEPTH + 1) // 2
    no = DEPTH // 2

    def nrm(k, shape, fan_in):
        return jax.random.normal(k, shape, jnp.float32) * (fan_in ** -0.5)

    def gain(k, shape):
        return 1.0 + 0.05 * jax.random.normal(k, shape, jnp.float32)

    return {
        'x': jax.random.normal(ks[0], (BATCH, SEQ, D_MODEL), jnp.float32),
        'mix_norm_g': gain(ks[1], (DEPTH, D_MODEL)),
        'mlp_norm_g': gain(ks[2], (DEPTH, D_MODEL)),
        'even_w_in': nrm(ks[3], (ne, D_MODEL, EVEN_IN), D_MODEL),
        'even_cmp_pe': 0.02 * jax.random.normal(ks[4], (ne, 2, CMP_BLOCK, HEAD_DIM), jnp.float32),
        'even_cmp_w1': nrm(ks[5], (ne, 2, CMP_BLOCK * HEAD_DIM, CMP_HIDDEN), CMP_BLOCK * HEAD_DIM),
        'even_cmp_w2': nrm(ks[6], (ne, 2, CMP_HIDDEN, HEAD_DIM), CMP_HIDDEN),
        'even_w_out': nrm(ks[7], (ne, EVEN_MIX, D_MODEL), EVEN_MIX),
        'odd_w_in': nrm(ks[8], (no, D_MODEL, ODD_IN), D_MODEL),
        'odd_lambda': 0.1 * jax.random.normal(ks[9], (no, 4, HEAD_DIM), jnp.float32),
        'odd_subln_g': gain(ks[10], (no, 2 * HEAD_DIM)),
        'odd_w_out': nrm(ks[11], (no, ODD_MIX, D_MODEL), ODD_MIX),
        'mlp_w_up': nrm(ks[12], (DEPTH, D_MODEL, D_FF), D_MODEL),
        'mlp_w_down': nrm(ks[13], (DEPTH, D_FF, D_MODEL), D_FF),
        'final_norm_g': gain(ks[14], (D_MODEL,)),
    }


def reference(x, mix_norm_g, mlp_norm_g, even_w_in, even_cmp_pe, even_cmp_w1, even_cmp_w2, even_w_out, odd_w_in, odd_lambda, odd_subln_g, odd_w_out, mlp_w_up, mlp_w_down, final_norm_g):
    T = x.shape[1]
    cos, sin = rope_tables(T)
    h = x
    for layer in range(DEPTH):
        u = rms_norm(h, mix_norm_g[layer])
        if layer % 2 == 0:
            e = layer // 2
            h = h + even_mixer(u, even_w_in[e], even_cmp_pe[e], even_cmp_w1[e], even_cmp_w2[e], even_w_out[e], cos, sin)
        else:
            o = layer // 2
            lambda_init = 0.8 - 0.6 * math.exp(-0.3 * layer)
            h = h + diff_mixer(u, odd_w_in[o], odd_lambda[o], odd_subln_g[o], odd_w_out[o], cos, sin, lambda_init)
        h = h + sq_relu_mlp(rms_norm(h, mlp_norm_g[layer]), mlp_w_up[layer], mlp_w_down[layer])
    return rms_norm(h, final_norm_g)
```

```cpp
#include <hip/hip_runtime.h>
#include <cstdio>
#include <cstdint>

#ifndef MK_ONE_LAUNCH
#define MK_ONE_LAUNCH 1
#endif

#define LAS __attribute__((address_space(3)))
#define GAS __attribute__((address_space(1)))
typedef unsigned short u16;
typedef _Float16 half8 __attribute__((ext_vector_type(8)));
typedef short s16x8 __attribute__((ext_vector_type(8)));
typedef float f32x4 __attribute__((ext_vector_type(4)));
typedef unsigned u32x4 __attribute__((ext_vector_type(4)));
typedef unsigned u32x2 __attribute__((ext_vector_type(2)));
typedef unsigned long long u64;

constexpr int NB = 4, T = 4096, M = NB * T, DM = 1024, DFF = 4096;
constexpr int EVEN_N = 2304, ODD_N = 3072;
constexpr int C_QA = 0, C_KA = 512, C_VA = 576, C_QI = 640, C_KI = 896, C_QB = 960, C_KVB = 1472, C_WI = 1984, C_GB = 1988;
constexpr int C_KC = C_KVB, C_VC = C_KVB + 128, C_KS = C_KVB + 256, C_VS = C_KVB + 384;
constexpr int C_KW0 = 2240, C_KW1 = 2048, C_VW = 2112;
constexpr float QSCALE = 0.125f * 1.4426950408889634f;

__device__ const float ROPE_INV[32] = {
    1.000000000e+00f, 7.498942018e-01f, 5.623413324e-01f, 4.216965139e-01f, 3.162277639e-01f, 2.371373922e-01f, 1.778279394e-01f, 1.333521456e-01f,
    1.000000015e-01f, 7.498941571e-02f, 5.623412877e-02f, 4.216964915e-02f, 3.162277862e-02f, 2.371373586e-02f, 1.778279431e-02f, 1.333521493e-02f,
    9.999999776e-03f, 7.498942316e-03f, 5.623413250e-03f, 4.216964822e-03f, 3.162277862e-03f, 2.371373819e-03f, 1.778279431e-03f, 1.333521446e-03f,
    1.000000047e-03f, 7.498941850e-04f, 5.623413017e-04f, 4.216965463e-04f, 3.162277862e-04f, 2.371373848e-04f, 1.778279402e-04f, 1.333521504e-04f};

template <class Tp> __device__ __forceinline__ Tp* G(Tp* p) { return (Tp*)(GAS Tp*)p; }
__device__ __forceinline__ unsigned pkh(float a, float b) { auto v = __builtin_amdgcn_cvt_pkrtz(a, b); return __builtin_bit_cast(unsigned, v); }
__device__ __forceinline__ float h2f(unsigned x) { return (float)__builtin_bit_cast(_Float16, (u16)x); }
__device__ __forceinline__ float wave_sum(float v) {
#pragma unroll
    for (int o = 1; o < 64; o <<= 1) v += __shfl_xor(v, o);
    return v;
}
__device__ __forceinline__ float wave_max(float v) {
#pragma unroll
    for (int o = 1; o < 64; o <<= 1) v = fmaxf(v, __shfl_xor(v, o));
    return v;
}
__device__ __forceinline__ void unpack8(const u32x4 w, float* f) {
    f[0] = h2f(w.x & 0xffffu); f[1] = h2f(w.x >> 16); f[2] = h2f(w.y & 0xffffu); f[3] = h2f(w.y >> 16);
    f[4] = h2f(w.z & 0xffffu); f[5] = h2f(w.z >> 16); f[6] = h2f(w.w & 0xffffu); f[7] = h2f(w.w >> 16);
}

namespace pg8 {
constexpr int BM = 256, BK = 64, HALF = 128, HTB = HALF * BK * 2, STAGE_BYTES = 8 * HTB, NXCD = 8, WGM = 8;
__host__ __device__ __forceinline__ int lds_byte(int r, int c) { const int st = (r >> 4) * 2 + (c >> 5), rr = r & 15, cc = c & 31, ob = rr * 64 + cc * 2; return st * 1024 + (ob ^ (((ob >> 9) & 1) << 5)); }
__host__ __device__ __forceinline__ void stage_rc(int b, int& R, int& C) { const int st = b / 1024, sb = b % 1024, swz = sb ^ (((sb >> 9) & 1) << 5); R = (st >> 1) * 16 + swz / 64; C = (st & 1) * 32 + (swz % 64) / 2; }
__host__ __device__ __forceinline__ int perm32(int rho) { const int n = rho >> 4, i = rho & 15; return 8 * (i >> 2) + 4 * n + (i & 3); }

struct Unit { int pm, pn; };
struct Gemm { const u16* A; const u16* Bt; int M, N, K; };

struct StaticOrder {
    int nM, nN, nwg, G, c;
    __host__ __device__ void init(int M_, int N_, int G_, int c_) { nM = M_ / BM; nN = N_ / BM; nwg = nM * nN; G = G_; c = c_; }
    __host__ __device__ bool next(int i, Unit& u) const {
        const long L = (long)i * G + c; if (L >= nwg) return false;
        int wgid = (int)L; { const int q = nwg / NXCD, r = nwg % NXCD, xcd = wgid % NXCD, off = wgid / NXCD; wgid = (xcd < r ? xcd * (q + 1) : r * (q + 1) + (xcd - r) * q) + off; }
        const int nig = WGM * nN, gid = wgid / nig, fm = gid * WGM, gsz = (nM - fm) < WGM ? (nM - fm) : WGM;
        u.pm = fm + ((wgid % nig) % gsz); u.pn = (wgid % nig) / gsz; return true;
    }
};
struct DiagOrder {
    int c, n;
    __host__ __device__ bool next(int i, Unit& u) const { if (i >= n || c >= 16) return false; u.pm = c; u.pn = c >> 3; return true; }
};

struct TailOrder {
    int c, n;
    __host__ __device__ bool next(int i, Unit& u) const { if (i >= n || c < 16 || c >= 80) return false; u.pm = c - 16; u.pn = 8; return true; }
};

__device__ __forceinline__ float rowscale(const float* psum, int row) {
    const GAS f32x4* p = (const GAS f32x4*)(psum + (size_t)row * 16);
    const f32x4 a = p[0], b = p[1], c = p[2], d = p[3];
    const float s = (((a.x + a.y) + (a.z + a.w)) + ((b.x + b.y) + (b.z + b.w))) + (((c.x + c.y) + (c.z + c.w)) + ((d.x + d.y) + (d.z + d.w)));
    return 1.0f / sqrtf(s * (1.0f / 1024.0f) + 1e-6f);
}

__device__ __forceinline__ void rowscales8(const float* psum, int rowbase  , int fq, float (&rs)[2][4]) {
    f32x4 ps[2][4];
#pragma unroll
    for (int ai = 0; ai < 2; ++ai)
#pragma unroll
        for (int m = 0; m < 4; ++m) ps[ai][m] = *(const GAS f32x4*)(psum + (size_t)(rowbase + ai * HALF + m * 16) * 16 + 4 * fq);
#pragma unroll
    for (int ai = 0; ai < 2; ++ai)
#pragma unroll
        for (int m = 0; m < 4; ++m) { float t = (ps[ai][m].x + ps[ai][m].y) + (ps[ai][m].z + ps[ai][m].w); t += __shfl_xor(t, 16); t += __shfl_xor(t, 32);
            rs[ai][m] = 1.0f / sqrtf(t * (1.0f / 1024.0f) + 1e-6f); }
}
struct EpiProj {
    static constexpr bool PERM = true, AFTER_DRAIN = false;
    u16* P; int ldp; const float* psum; const float* cosT; const float* sinT; u64 rope_mask, scale_mask; u16* kif;
    __device__ __forceinline__ void operator()(const f32x4 (&acc)[2][2][4][2], const Unit& u, int wr, int wc, int fr, int fq) const {
        const int d0 = 16 * (wc & 1) + 4 * fq, rowbase = u.pm * BM + wr * 64 + fr;
        float rs[2][4]; rowscales8(psum, rowbase, fq, rs);
        f32x4 cn, sn;
        { const int t = rowbase & (T - 1); cn = *(const GAS f32x4*)(cosT + t * 32 + d0); sn = *(const GAS f32x4*)(sinT + t * 32 + d0); }
#pragma unroll
        for (int ai = 0; ai < 2; ++ai)
#pragma unroll
            for (int m = 0; m < 4; ++m) {
                const int row = rowbase + ai * HALF + m * 16;
                const f32x4 c4 = cn, s4 = sn;
                if (ai * 4 + m < 7) { const int rn = rowbase + ((ai * 4 + m + 1) >> 2) * HALF + ((ai * 4 + m + 1) & 3) * 16, t = rn & (T - 1);
                    cn = *(const GAS f32x4*)(cosT + t * 32 + d0); sn = *(const GAS f32x4*)(sinT + t * 32 + d0); }
#pragma unroll
                for (int bj = 0; bj < 2; ++bj) {
                    const int head = u.pn * 4 + bj * 2 + (wc >> 1);
                    f32x4 v0 = acc[ai][bj][m][0] * rs[ai][m], v1 = acc[ai][bj][m][1] * rs[ai][m], o0 = v0, o1 = v1;
                    if ((rope_mask >> head) & 1ull) { o0 = v0 * c4 - v1 * s4; o1 = v1 * c4 + v0 * s4; }
                    if ((scale_mask >> head) & 1ull) { o0 = o0 * QSCALE; o1 = o1 * QSCALE; }
                    u16* dst = P + (size_t)row * ldp + head * 64 + d0;
                    u32x2 w0, w1; w0.x = pkh(o0[0], o0[1]); w0.y = pkh(o0[2], o0[3]); w1.x = pkh(o1[0], o1[1]); w1.y = pkh(o1[2], o1[3]);
                    *(GAS u32x2*)dst = w0; *(GAS u32x2*)(dst + 32) = w1;
                    if (kif != nullptr && head == 14) {
                        u16* kf = kif + ((size_t)(row >> 5) * 8 * 32 + (row & 31)) * 8;
                        const int dA = d0, dB = d0 + 32;
                        *(GAS u32x2*)(kf + (size_t)(((dA >> 4) * 2 + ((dA >> 3) & 1)) * 32) * 8 + (dA & 7)) = w0;
                        *(GAS u32x2*)(kf + (size_t)(((dB >> 4) * 2 + ((dB >> 3) & 1)) * 32) * 8 + (dB & 7)) = w1;
                    }
                }
            }
    }
};
struct EpiResid {
    static constexpr bool PERM = true, AFTER_DRAIN = false;
    const float* hin; float* h; u16* x16; float* psum;
    __device__ __forceinline__ void operator()(const f32x4 (&acc)[2][2][4][2], const Unit& u, int wr, int wc, int fr, int fq) const {
        const int rowbase = u.pm * BM + wr * 64 + fr, colbase = u.pn * BM + wc * 32 + 8 * fq;
        f32x4 nx[2][2];
#pragma unroll
        for (int bj = 0; bj < 2; ++bj) { const float* p = hin + (size_t)rowbase * DM + colbase + bj * HALF; nx[bj][0] = *(const GAS f32x4*)p; nx[bj][1] = *(const GAS f32x4*)(p + 4); }
#pragma unroll
        for (int ai = 0; ai < 2; ++ai)
#pragma unroll
            for (int m = 0; m < 4; ++m) {
                const int row = rowbase + ai * HALF + m * 16; float ss = 0.f;
                f32x4 cu[2][2];
#pragma unroll
                for (int bj = 0; bj < 2; ++bj) { cu[bj][0] = nx[bj][0]; cu[bj][1] = nx[bj][1]; }
                if (ai * 4 + m < 7) { const int rn = rowbase + ((ai * 4 + m + 1) >> 2) * HALF + ((ai * 4 + m + 1) & 3) * 16;
#pragma unroll
                    for (int bj = 0; bj < 2; ++bj) { const float* p = hin + (size_t)rn * DM + colbase + bj * HALF; nx[bj][0] = *(const GAS f32x4*)p; nx[bj][1] = *(const GAS f32x4*)(p + 4); } }
#pragma unroll
                for (int bj = 0; bj < 2; ++bj) {
                    const int col = colbase + bj * HALF;
                    float* hp = h + (size_t)row * DM + col;
                    const f32x4 a = cu[bj][0] + acc[ai][bj][m][0], b = cu[bj][1] + acc[ai][bj][m][1];
                    *(GAS f32x4*)hp = a; *(GAS f32x4*)(hp + 4) = b;
                    ss += (a.x * a.x + a.y * a.y) + (a.z * a.z + a.w * a.w) + (b.x * b.x + b.y * b.y) + (b.z * b.z + b.w * b.w);
                    u32x4 w; w.x = pkh(a.x, a.y); w.y = pkh(a.z, a.w); w.z = pkh(b.x, b.y); w.w = pkh(b.z, b.w);
                    *(GAS u32x4*)(x16 + (size_t)row * DM + col) = w;
                }
                ss += __shfl_xor(ss, 16); ss += __shfl_xor(ss, 32);
                if (fq == 0) ((GAS float*)psum)[(size_t)row * 16 + u.pn * 4 + wc] = ss;
            }
    }
};
struct EpiUp {
    static constexpr bool PERM = true, AFTER_DRAIN = false;
    u16* U; int ldc; const float* psum;
    __device__ __forceinline__ void operator()(const f32x4 (&acc)[2][2][4][2], const Unit& u, int wr, int wc, int fr, int fq) const {
        const int rowbase = u.pm * BM + wr * 64 + fr;
        float rs[2][4]; rowscales8(psum, rowbase, fq, rs);
#pragma unroll
        for (int ai = 0; ai < 2; ++ai)
#pragma unroll
            for (int m = 0; m < 4; ++m) {
                const int row = rowbase + ai * HALF + m * 16;
#pragma unroll
                for (int bj = 0; bj < 2; ++bj) {
                    const int col = u.pn * BM + bj * HALF + wc * 32 + 8 * fq;
                    f32x4 a = acc[ai][bj][m][0] * rs[ai][m], b = acc[ai][bj][m][1] * rs[ai][m];
#pragma unroll
                    for (int i = 0; i < 4; ++i) { a[i] = fmaxf(a[i], 0.f); a[i] *= a[i]; b[i] = fmaxf(b[i], 0.f); b[i] *= b[i]; }
                    u32x4 w; w.x = pkh(a.x, a.y); w.y = pkh(a.z, a.w); w.z = pkh(b.x, b.y); w.w = pkh(b.z, b.w);
                    *(GAS u32x4*)(U + (size_t)row * ldc + col) = w;
                }
            }
    }
};
__device__ __forceinline__ float gelu_tanh(float x) {
    const float u = x * (1.5957691216057308f + 0.07135481627f * x * x);
    return x * __builtin_amdgcn_rcpf(1.0f + __builtin_amdgcn_exp2f(-1.4426950408889634f * u));
}
template <int ACT> struct EpiCmp {
    static constexpr bool PERM = true, AFTER_DRAIN = false;
    u16* O;
    __device__ __forceinline__ void operator()(const f32x4 (&acc)[2][2][4][2], const Unit& u, int wr, int wc, int fr, int fq) const {
#pragma unroll
        for (int ai = 0; ai < 2; ++ai)
#pragma unroll
            for (int m = 0; m < 4; ++m) {
                const int row = u.pm * BM + ai * HALF + wr * 64 + m * 16 + fr;
#pragma unroll
                for (int bj = 0; bj < 2; ++bj) {
                    const int col = bj * HALF + wc * 32 + 8 * fq;
                    f32x4 a = acc[ai][bj][m][0], b = acc[ai][bj][m][1];
                    if (ACT == 1) {
#pragma unroll
                        for (int i = 0; i < 4; ++i) { a[i] = gelu_tanh(a[i]); b[i] = gelu_tanh(b[i]); }
                    }
                    u32x4 w; w.x = pkh(a.x, a.y); w.y = pkh(a.z, a.w); w.z = pkh(b.x, b.y); w.w = pkh(b.z, b.w);
                    *(GAS u32x4*)(O + (size_t)row * 256 + col) = w;
                    asm volatile("" ::: "memory"); __builtin_amdgcn_sched_barrier(0);
                }
            }
    }
};

template <class Epi, class Sched, bool ALIGN_EPI = false, bool SP2 = false>
__device__ __forceinline__ void gemm_phase(LAS unsigned char* lds, const int tid, const Gemm g, const Sched& S, const Epi& E) {
    const int wid = __builtin_amdgcn_readfirstlane(tid >> 6), lane = tid & 63, wr = wid >> 2, wc = wid & 3, fr = lane & 15, fq = lane >> 4;
    const int K = g.K, nt = K / BK;
    unsigned voffA[2], voffB[2];
#pragma unroll
    for (int i = 0; i < 2; ++i) { int R, C; stage_rc(tid * 16 + i * 8192, R, C); const int Rb = Epi::PERM ? ((R & ~31) + perm32(R & 31)) : R;
        voffA[i] = (unsigned)(R * K + C) * 2u; voffB[i] = (unsigned)(Rb * K + C) * 2u; }
    const size_t kstep = (size_t)(BK * 2);
    const size_t hstep = (size_t)HALF * K * 2;
    const size_t tstep = 2 * hstep;
    const unsigned ldsw = (unsigned)wid * 1024u;
    const int aoff = lds_byte(wr * 64 + fr, fq * 8), boff = lds_byte(wc * 32 + fr, fq * 8);
#define PG8_SA(b, h) (((b) * 2 + (h)) * HTB)
#define PG8_SB(b, h) ((4 + (b) * 2 + (h)) * HTB)
#define PG8_STAGE(bufoff, gbase, voff) do { _Pragma("unroll") for (int _i = 0; _i < 2; ++_i) \
        __builtin_amdgcn_global_load_lds((const unsigned*)((const char*)(gbase) + (voff)[_i]), (LAS unsigned*)(lds + (bufoff) + ldsw + _i * 8192), 16, 0, 0); } while (0)
#define PG8_LDA(dst, b, h) do { _Pragma("unroll") for (int m = 0; m < 4; ++m) _Pragma("unroll") for (int k = 0; k < 2; ++k) dst[m][k] = *(const LAS half8*)(lds + PG8_SA(b, h) + aoff + m * 2048 + k * 1024); } while (0)
#define PG8_LDB(dst, b, h) do { _Pragma("unroll") for (int n = 0; n < 2; ++n) _Pragma("unroll") for (int k = 0; k < 2; ++k) dst[n][k] = *(const LAS half8*)(lds + PG8_SB(b, h) + boff + n * 2048 + k * 1024); } while (0)
#define PG8_MMA(ai, bj, At, Bt) do { __builtin_amdgcn_s_setprio(1); _Pragma("unroll") for (int m = 0; m < 4; ++m) _Pragma("unroll") for (int n = 0; n < 2; ++n) _Pragma("unroll") for (int k = 0; k < 2; ++k) \
        acc[ai][bj][m][n] = __builtin_amdgcn_mfma_f32_16x16x32_f16(Bt[n][k], At[m][k], acc[ai][bj][m][n], 0, 0, 0); __builtin_amdgcn_s_setprio(0); } while (0)
#define PG8_WAIT_V(n) asm volatile("s_waitcnt vmcnt(" #n ")" ::: "memory")
#define PG8_WAIT_L(n) asm volatile("s_waitcnt lgkmcnt(" #n ")" ::: "memory")
#define PG8_BAR __builtin_amdgcn_s_barrier()
#define PG8_SCHED __builtin_amdgcn_sched_barrier(0)
    Unit cur, nxt; int ui = 0;
    if (!S.next(0, cur)) return;
    f32x4 acc[2][2][4][2];
#pragma unroll
    for (int a = 0; a < 2; ++a)
#pragma unroll
        for (int b = 0; b < 2; ++b)
#pragma unroll
            for (int m = 0; m < 4; ++m)
#pragma unroll
                for (int n = 0; n < 2; ++n) acc[a][b][m][n] = (f32x4){0.f, 0.f, 0.f, 0.f};
    half8 At[4][2], B0[2][2], B1[2][2];
    const char* cA = (const char*)g.A + (size_t)cur.pm * tstep; const char* cB = (const char*)g.Bt + (size_t)cur.pn * tstep;
    if constexpr (SP2) {
        PG8_STAGE(PG8_SB(0, 0), cB, voffB); PG8_STAGE(PG8_SB(0, 1), cB + hstep, voffB); PG8_STAGE(PG8_SA(0, 0), cA, voffA); PG8_STAGE(PG8_SA(0, 1), cA + hstep, voffA);
        if (wr == 1) PG8_BAR;
        PG8_WAIT_V(2); PG8_BAR;
        PG8_STAGE(PG8_SB(1, 0), cB + kstep, voffB); PG8_STAGE(PG8_SA(1, 0), cA + kstep, voffA); PG8_STAGE(PG8_SB(1, 1), cB + hstep + kstep, voffB);
        PG8_WAIT_V(6); PG8_BAR;
    } else {
        PG8_STAGE(PG8_SB(0, 0), cB, voffB); PG8_STAGE(PG8_SA(0, 0), cA, voffA); PG8_STAGE(PG8_SB(0, 1), cB + hstep, voffB); PG8_STAGE(PG8_SA(0, 1), cA + hstep, voffA);
        if (wr == 1) PG8_BAR;
        PG8_WAIT_V(4); PG8_BAR;
        PG8_STAGE(PG8_SB(1, 0), cB + kstep, voffB); PG8_STAGE(PG8_SA(1, 0), cA + kstep, voffA); PG8_STAGE(PG8_SB(1, 1), cB + hstep + kstep, voffB);
        PG8_WAIT_V(6); PG8_BAR;
    }
    for (;;) {
        const bool has_next = S.next(ui + 1, nxt);
        const char* nA = has_next ? (const char*)g.A + (size_t)nxt.pm * tstep : cA; const char* nB = has_next ? (const char*)g.Bt + (size_t)nxt.pn * tstep : cB;
        for (int t = 0; t < nt; t += 2) {
            const bool last = (t == nt - 2);
            const char* a1 = cA + (size_t)(t + 1) * kstep;
            const char* a2 = last ? nA : cA + (size_t)(t + 2) * kstep; const char* b2 = last ? nB : cB + (size_t)(t + 2) * kstep;
            const char* a3 = a2 + kstep; const char* b3 = b2 + kstep;
            if constexpr (SP2) {
            PG8_LDB(B0, 0, 0); PG8_LDB(B1, 0, 1); PG8_SCHED; PG8_LDA(At, 0, 0); PG8_STAGE(PG8_SA(1, 1), a1 + hstep, voffA);
            PG8_WAIT_V(8); PG8_WAIT_L(0); PG8_BAR; PG8_MMA(0, 0, At, B0); PG8_MMA(0, 1, At, B1); PG8_BAR; PG8_SCHED;
            PG8_LDA(At, 0, 1); PG8_STAGE(PG8_SB(0, 0), b2, voffB); PG8_STAGE(PG8_SB(0, 1), b2 + hstep, voffB); PG8_STAGE(PG8_SA(0, 0), a2, voffA);
            PG8_WAIT_V(8); PG8_WAIT_L(0); PG8_BAR; PG8_MMA(1, 0, At, B0); PG8_MMA(1, 1, At, B1); PG8_BAR; PG8_SCHED;
            PG8_LDB(B0, 1, 0); PG8_LDB(B1, 1, 1); PG8_SCHED; PG8_LDA(At, 1, 0); PG8_STAGE(PG8_SA(0, 1), a2 + hstep, voffA);
            PG8_WAIT_V(8); PG8_WAIT_L(0); PG8_BAR; PG8_MMA(0, 0, At, B0); PG8_MMA(0, 1, At, B1); PG8_BAR; PG8_SCHED;
            PG8_LDA(At, 1, 1); PG8_STAGE(PG8_SB(1, 0), b3, voffB); PG8_STAGE(PG8_SB(1, 1), b3 + hstep, voffB); PG8_STAGE(PG8_SA(1, 0), a3, voffA);
            PG8_WAIT_V(8); PG8_WAIT_L(0); PG8_BAR; PG8_MMA(1, 0, At, B0); PG8_MMA(1, 1, At, B1); PG8_BAR; PG8_SCHED;
            } else {
            PG8_LDB(B0, 0, 0); PG8_SCHED; PG8_LDA(At, 0, 0); PG8_STAGE(PG8_SA(1, 1), a1 + hstep, voffA);
            PG8_WAIT_L(8); PG8_BAR; PG8_WAIT_L(0); PG8_MMA(0, 0, At, B0); PG8_BAR; PG8_SCHED;
            PG8_LDB(B1, 0, 1); PG8_STAGE(PG8_SB(0, 0), b2, voffB);
            PG8_BAR; PG8_WAIT_L(0); PG8_MMA(0, 1, At, B1); PG8_BAR;
            PG8_LDA(At, 0, 1); PG8_STAGE(PG8_SA(0, 0), a2, voffA);
            PG8_BAR; PG8_WAIT_L(0); PG8_MMA(1, 0, At, B0); PG8_BAR; PG8_SCHED;
            PG8_STAGE(PG8_SB(0, 1), b2 + hstep, voffB);
            PG8_WAIT_V(6); PG8_BAR; PG8_MMA(1, 1, At, B1); PG8_BAR;
            PG8_LDB(B0, 1, 0); PG8_SCHED; PG8_LDA(At, 1, 0); PG8_STAGE(PG8_SA(0, 1), a2 + hstep, voffA);
            PG8_WAIT_L(8); PG8_BAR; PG8_WAIT_L(0); PG8_MMA(0, 0, At, B0); PG8_BAR; PG8_SCHED;
            PG8_LDB(B1, 1, 1); PG8_STAGE(PG8_SB(1, 0), b3, voffB);
            PG8_BAR; PG8_WAIT_L(0); PG8_MMA(0, 1, At, B1); PG8_BAR;
            PG8_LDA(At, 1, 1); PG8_STAGE(PG8_SA(1, 0), a3, voffA);
            PG8_BAR; PG8_WAIT_L(0); PG8_MMA(1, 0, At, B0); PG8_BAR; PG8_SCHED;
            PG8_STAGE(PG8_SB(1, 1), b3 + hstep, voffB);
            PG8_WAIT_V(6); PG8_BAR; PG8_MMA(1, 1, At, B1); PG8_BAR;
            }
        }
        if constexpr (ALIGN_EPI) { if (wr == 0) PG8_BAR; }
        E(acc, cur, wr, wc, fr, fq);
        if (!has_next) break;
#pragma unroll
        for (int a = 0; a < 2; ++a)
#pragma unroll
            for (int b = 0; b < 2; ++b)
#pragma unroll
                for (int m = 0; m < 4; ++m)
#pragma unroll
                    for (int n = 0; n < 2; ++n) acc[a][b][m][n] = (f32x4){0.f, 0.f, 0.f, 0.f};
        cur = nxt; cA = nA; cB = nB; ++ui;
        if constexpr (ALIGN_EPI) { if (wr == 1) PG8_BAR; }
    }
    PG8_WAIT_V(0);
    if constexpr (!ALIGN_EPI) { if (wr == 0) PG8_BAR; }
    PG8_BAR;
#undef PG8_SA
#undef PG8_SB
#undef PG8_STAGE
#undef PG8_LDA
#undef PG8_LDB
#undef PG8_MMA
#undef PG8_WAIT_V
#undef PG8_WAIT_L
#undef PG8_BAR
#undef PG8_SCHED
}
}

constexpr size_t MiB = 1u << 20;
constexpr size_t WS_CTL = 0, CTL_ZERO_BYTES = 64 * 1024;
constexpr size_t WS_COS = 1 * MiB, WS_SIN = 1 * MiB + 512 * 1024;
constexpr size_t WS_PSUM = 2 * MiB;
constexpr size_t WS_WIN = 4 * MiB, WS_WOUT = 10 * MiB, WS_WUP = 12 * MiB, WS_WDN = 20 * MiB, WS_WC1 = 28 * MiB, WS_WC2 = 30 * MiB;
constexpr size_t WS_X16 = 32 * MiB;
constexpr size_t WS_O16 = 64 * MiB;
constexpr size_t WS_P = 96 * MiB;
constexpr size_t WS_U = 96 * MiB;
constexpr size_t WS_AC = 168 * MiB;
constexpr size_t WS_HC = 184 * MiB;
constexpr size_t WS_KVC = 186 * MiB;
constexpr size_t WS_MASK = 188 * MiB;
constexpr size_t WS_KIF = 196 * MiB;
constexpr size_t WS_END = 224 * MiB;
constexpr int CW_BAR = 1024;

constexpr int RING_BYTES = 131072, WSCR_OFF = 131072, LDSCTL_OFF = 139264, MISC_OFF = LDSCTL_OFF + 64, LDS_BYTES = 147456;

#define XB_TMO      128
#define XB_XCNT(j)  (256  + 64 * (j))
#define XB_XSUB(j)  (1280 + 64 * (j))
#define XB_XGEN(j)  (2304 + 64 * (j))
#define XB_TOP      3328
#define XB_TOPGEN   3392
#define XCD_BAR_WORDS 3456
#define XB_SPIN_CAP (1u << 20)
__device__ __forceinline__ unsigned xb_ld(unsigned* p)              { return __hip_atomic_load(p, __ATOMIC_RELAXED, __HIP_MEMORY_SCOPE_AGENT); }
__device__ __forceinline__ unsigned xb_add(unsigned* p, unsigned v) { return __hip_atomic_fetch_add(p, v, __ATOMIC_RELAXED, __HIP_MEMORY_SCOPE_AGENT); }
__device__ __forceinline__ unsigned xb_xcc_id() { return (unsigned)__builtin_amdgcn_s_getreg((3 << 11) | 20) & 0xFu; }
#define XB_SPIN(cond, bar) do { unsigned _sp = 0; while (cond) { __builtin_amdgcn_s_sleep(1); \
    if ((++_sp & 255u) == 0u) { if (xb_ld(&(bar)[XB_TMO])) break; if (_sp > XB_SPIN_CAP) { atomicAdd(&(bar)[XB_TMO], 1u); break; } } } } while (0)
struct XcdBarrier { unsigned* bar; unsigned x; volatile LAS unsigned* st; };
__device__ __forceinline__ XcdBarrier xcd_barrier_post(unsigned* bar, volatile LAS unsigned* st) {
    XcdBarrier b; b.bar = bar; b.x = xb_xcc_id(); b.st = st;
    if (threadIdx.x == 0) (void)xb_add(&bar[XB_XCNT(b.x)], 1u);
    return b;
}
__device__ __forceinline__ void xcd_barrier_complete(unsigned* bar, unsigned x, unsigned& nloc, unsigned& nx) {
    const unsigned G = gridDim.x * gridDim.y * gridDim.z;
    unsigned sum, cnt, mine, sp = 0u;
    for (;;) {
        sum = 0u; cnt = 0u; mine = 0u;
#pragma unroll
        for (unsigned j = 0; j < 16; ++j) { const unsigned c = xb_ld(&bar[XB_XCNT(j)]); sum += c; cnt += (c > 0u) ? 1u : 0u; mine = (j == x) ? c : mine; }
        if (sum == G) break;
        __builtin_amdgcn_s_sleep(1);
        if ((++sp & 255u) == 0u) { if (xb_ld(&bar[XB_TMO])) break; if (sp > XB_SPIN_CAP) { atomicAdd(&bar[XB_TMO], 1u); break; } }
    }
    nloc = mine > 0u ? mine : 1u; nx = cnt > 0u ? cnt : 1u;
}
__device__ __forceinline__ void xcd_barrier(const XcdBarrier& b) {
    asm volatile("s_waitcnt vmcnt(0)" ::: "memory");
    __syncthreads();
    if (threadIdx.x == 0) {
        unsigned* bar = b.bar; asm volatile("" : "+s"(bar));
        __builtin_amdgcn_s_waitcnt(0);
        unsigned nloc = b.st[0], nx = b.st[1];
        if (nloc == 0u) { xcd_barrier_complete(bar, b.x, nloc, nx); b.st[0] = nloc; b.st[1] = nx; }
        const unsigned old = xb_add(&bar[XB_XSUB(b.x)], 1u);
        const unsigned gen = old / nloc;
        if (old + 1u == (gen + 1u) * nloc) {
            __builtin_amdgcn_fence(__ATOMIC_RELEASE, "agent");
            asm volatile("s_waitcnt vmcnt(0)" ::: "memory");
            const unsigned og = xb_add(&bar[XB_TOP], 1u);
            const unsigned tg = og / nx;
            if (og + 1u == (tg + 1u) * nx) xb_add(&bar[XB_TOPGEN], 1u);
            else XB_SPIN(xb_ld(&bar[XB_TOPGEN]) == tg, bar);
            __builtin_amdgcn_fence(__ATOMIC_ACQUIRE, "agent");
            xb_add(&bar[XB_XGEN(b.x)], 1u);
            asm volatile("s_waitcnt vmcnt(0)" ::: "memory");
        } else {
            XB_SPIN(xb_ld(&bar[XB_XGEN(b.x)]) == gen, bar);
            __builtin_amdgcn_fence(__ATOMIC_ACQUIRE, "agent");
            asm volatile("s_waitcnt vmcnt(0)" ::: "memory");
        }
    }
    __syncthreads();
}

struct Args {
    const float* x; const float* mix_g; const float* mlp_g; const float* even_w_in; const float* even_pe; const float* even_w1; const float* even_w2; const float* even_w_out;
    const float* odd_w_in; const float* odd_lambda; const float* odd_subln; const float* odd_w_out; const float* mlp_up; const float* mlp_down; const float* final_g;
    float* out; unsigned char* ws; int ph_lo, ph_hi;
};
typedef const __attribute__((address_space(4))) Args* ArgsP;
struct Frame {
    LAS unsigned char* lds; int tid, lane, wave, G, bid;
    ArgsP a; unsigned char* ws;
};
__device__ __forceinline__ ArgsP kargs() { ArgsP p = (ArgsP)__builtin_amdgcn_kernarg_segment_ptr(); asm volatile("" : "+s"(p)); return p; }

enum { K_PREP = 0, K_INPROJ, K_PRE, K_CMP1, K_CMP2, K_ATTN, K_OUTPROJ, K_UP, K_DOWN, K_FINAL };
constexpr int NPHASE = 31;
__host__ __device__ __forceinline__ void phase_decode(int ph, int& layer, int& kind) {
    if (ph >= 30) { layer = 4; kind = K_FINAL; return; }
    int base;
    if (ph < 9) { layer = 0; base = 0; } else if (ph < 15) { layer = 1; base = 9; } else if (ph < 24) { layer = 2; base = 15; } else { layer = 3; base = 24; }
    const int i = ph - base;
    if (layer & 1) kind = (i == 0) ? K_PREP : (i == 1) ? K_INPROJ : (i == 2) ? K_ATTN : (i == 3) ? K_OUTPROJ : (i == 4) ? K_UP : K_DOWN;
    else kind = i;
}

__device__ __forceinline__ int storage_row(int c) {
    const int head = c >> 6, d = c & 63;
    const int s = (d < 32) ? ((d >> 2) * 8 + (d & 3)) : (((d - 32) >> 2) * 8 + 4 + (d & 3));
    return head * 64 + s;
}
template <int MAP>
__device__ __forceinline__ void conv_weight(const Frame& F, const float* src, int K, int N, u16* dst, const float* gain) {
    const int gtid = F.bid * 512 + F.tid, GT = F.G * 512;
    const int total = N * (K / 8);
    for (int i0 = gtid; i0 < total; i0 += 2 * GT) {
        float v[2][8]; int nn[2], kk[2]; bool ok[2];
#pragma unroll
        for (int c = 0; c < 2; ++c) { const int i = i0 + c * GT; ok[c] = i < total; const int ii = ok[c] ? i : i0; nn[c] = ii % N; kk[c] = (ii / N) * 8;
#pragma unroll
            for (int j = 0; j < 8; ++j) v[c][j] = ((const GAS float*)src)[(size_t)(kk[c] + j) * N + nn[c]]; }
#pragma unroll
        for (int c = 0; c < 2; ++c) {
            if (gain) {
#pragma unroll
                for (int j = 0; j < 8; ++j) v[c][j] *= ((const GAS float*)gain)[kk[c] + j]; }
            int r = nn[c];
            if (MAP == 1) { int cc = nn[c];
                if (cc >= 960 && cc < 964) cc = cc - 960 + C_WI;
                else if (cc >= 964 && cc < 1476) cc = cc - 4;
                else if (cc >= 1476 && cc < 2244) { const int j = cc - 1476, idx = j >> 7, gg = (j >> 6) & 1, d = j & 63;
                    cc = (idx < 4) ? (C_KVB + j) : (idx == 4) ? ((gg ? C_KW1 : C_KW0) + d) : (C_VW + gg * 64 + d); }
                else if (cc >= 2244) cc = cc - 2244 + C_GB;
                r = storage_row(cc); }
            if (MAP == 2) r = storage_row(nn[c]);
            u32x4 w; w.x = pkh(v[c][0], v[c][1]); w.y = pkh(v[c][2], v[c][3]); w.z = pkh(v[c][4], v[c][5]); w.w = pkh(v[c][6], v[c][7]);
            if (ok[c]) *(GAS u32x4*)(dst + (size_t)r * K + kk[c]) = w;
        }
    }
}

__device__ __forceinline__ void prep_phase(const Frame& F, int layer) {
    const ArgsP ap = F.a; unsigned char* ws = F.ws;
    const int gtid = F.bid * 512 + F.tid, GT = F.G * 512;
    if (layer == 0) {
        float* cosT = (float*)(ws + WS_COS); float* sinT = (float*)(ws + WS_SIN);
        for (int i = gtid; i < T * 32; i += GT) {
            const int t = i >> 5, k = i & 31;
            const float ang = (float)t * ROPE_INV[k];
            double r = (double)ang * 0.15915494309189535; r -= rint(r);
            cosT[i] = __builtin_amdgcn_cosf((float)r); sinT[i] = __builtin_amdgcn_sinf((float)r);
        }
        const int gw = F.bid * 8 + F.wave, NGW = F.G * 8;
        float* psum = (float*)(ws + WS_PSUM); u16* x16 = (u16*)(ws + WS_X16);
        for (int row = gw; row < M; row += NGW) {
            const f32x4* xr = (const f32x4*)(G(ap->x) + (size_t)row * DM) + F.lane;
            u32x2* hrow = (u32x2*)(x16 + (size_t)row * DM) + F.lane;
            float s = 0.f;
#pragma unroll
            for (int j = 0; j < 4; ++j) { const f32x4 v = xr[64 * j]; s += (v.x * v.x + v.y * v.y) + (v.z * v.z + v.w * v.w);
                u32x2 w; w.x = pkh(v.x, v.y); w.y = pkh(v.z, v.w); hrow[64 * j] = w; }
            s = wave_sum(s);
            if (F.lane < 16) psum[(size_t)row * 16 + F.lane] = (F.lane == 0) ? s : 0.f;
        }
    }
    const int e = layer >> 1;
    if (layer & 1) {
        conv_weight<2>(F, G(ap->odd_w_in) + (size_t)e * DM * ODD_N, DM, ODD_N, (u16*)(ws + WS_WIN), G(ap->mix_g) + layer * DM);
        conv_weight<0>(F, G(ap->odd_w_out) + (size_t)e * DM * DM, DM, DM, (u16*)(ws + WS_WOUT), nullptr);
    } else {
        conv_weight<1>(F, G(ap->even_w_in) + (size_t)e * DM * 2268, DM, 2268, (u16*)(ws + WS_WIN), G(ap->mix_g) + layer * DM);
        conv_weight<0>(F, G(ap->even_w_out) + (size_t)e * DM * DM, DM, DM, (u16*)(ws + WS_WOUT), nullptr);
        conv_weight<0>(F, G(ap->even_w1) + (size_t)(e * 2 + 0) * 2048 * 256, 2048, 256, (u16*)(ws + WS_WC1), nullptr);
        conv_weight<0>(F, G(ap->even_w1) + (size_t)(e * 2 + 1) * 2048 * 256, 2048, 256, (u16*)(ws + WS_WC1) + (size_t)256 * 2048, nullptr);
        conv_weight<0>(F, G(ap->even_w2) + (size_t)(e * 2 + 0) * 256 * 64, 256, 64, (u16*)(ws + WS_WC2), nullptr);
        conv_weight<0>(F, G(ap->even_w2) + (size_t)(e * 2 + 1) * 256 * 64, 256, 64, (u16*)(ws + WS_WC2) + (size_t)256 * 256, nullptr);
    }
    conv_weight<0>(F, G(ap->mlp_up) + (size_t)layer * DM * DFF, DM, DFF, (u16*)(ws + WS_WUP), G(ap->mlp_g) + layer * DM);
    if ((layer & 1) || F.G <= 80)
        conv_weight<0>(F, G(ap->mlp_down) + (size_t)layer * DFF * DM, DFF, DM, (u16*)(ws + WS_WDN), nullptr);
}

__device__ __forceinline__ unsigned sortable(float f) {
    if (f == 0.f) f = 0.f;
    const unsigned b = __float_as_uint(f);
    return (b & 0x80000000u) ? ~b : (b | 0x80000000u);
}
__device__ __forceinline__ int wave_isum(int v) {
#pragma unroll
    for (int o = 1; o < 64; o <<= 1) v += __shfl_xor(v, o);
    return v;
}
__device__ __forceinline__ void select_row(LAS unsigned* ub, int t, u64* maskrow, int lane, LAS unsigned* wscr) {
    unsigned u[64];
#pragma unroll
    for (int j = 0; j < 64; ++j) { const int s = j * 64 + lane; const unsigned v = ub[s]; u[j] = (s <= t) ? v : 0u; }
    const int n = t + 1;
    unsigned L = 1u;
    if (n > 704) {
        int ns = 0;
#pragma unroll
        for (int i = 0; i < 8; ++i) { int c = n - 512 * i; c = c < 0 ? 0 : (c > 64 ? 64 : c); ns += c; }
        const int cs_lo = (380 * ns + n - 1) / n, cs_hi = (620 * ns) / n;
        unsigned ts = 0u;
        for (int bit = 31; bit >= 0; --bit) {
            const unsigned cand = ts | (1u << bit);
            int cs = 0;
#pragma unroll
            for (int i = 0; i < 8; ++i) cs += __popcll(__ballot(u[8 * i] >= cand));
            if (cs >= cs_lo) { ts = cand; if (cs <= cs_hi) break; }
        }
        L = ts > 1u ? ts : 1u;
    }
    int C = 0;
    asm volatile("s_waitcnt lgkmcnt(0)" ::: "memory");
#pragma unroll
    for (int j = 0; j < 64; ++j) {
        const bool pr = u[j] >= L; const u64 bal = __ballot(pr);
        const int pos = C + (int)__builtin_amdgcn_mbcnt_hi((unsigned)(bal >> 32), __builtin_amdgcn_mbcnt_lo((unsigned)bal, 0u));
        ub[(pr && pos < 704) ? pos : 704 + lane] = u[j];
        C += __popcll(bal);
    }
    asm volatile("s_waitcnt lgkmcnt(0)" ::: "memory");
    unsigned thr = 0u; int need;
    if (C >= 256 && C <= 704) {
        unsigned v[11];
#pragma unroll
        for (int i = 0; i < 11; ++i) { const int p = i * 64 + lane; const unsigned x = ub[p]; v[i] = (p < C) ? x : 0u; }
        bool exact = false;
        for (int bit = 31; bit >= 0; --bit) {
            const unsigned cand = thr | (1u << bit);
            int cnt = 0;
#pragma unroll
            for (int i = 0; i < 11; ++i) cnt += __popcll(__ballot(v[i] >= cand));
            if (cnt >= 256) { thr = cand; if (cnt == 256) { exact = true; break; } }
        }
        if (exact) need = 1 << 20;
        else { int cg = 0, cge = 0;
#pragma unroll
            for (int i = 0; i < 11; ++i) { cg += __popcll(__ballot(v[i] > thr)); cge += __popcll(__ballot(v[i] >= thr)); }
            need = (cge == 256) ? (1 << 20) : 256 - cg; }
    } else {
        bool exact = false;
        for (int bit = 31; bit >= 0; --bit) {
            const unsigned cand = thr | (1u << bit);
            int c0 = 0, c1 = 0;
#pragma unroll
            for (int j = 0; j < 64; j += 2) { c0 += (u[j] >= cand) ? 1 : 0; c1 += (u[j + 1] >= cand) ? 1 : 0; }
            const int cnt = wave_isum(c0 + c1);
            if (cnt >= 256) { thr = cand; if (cnt == 256) { exact = true; break; } }
        }
        if (exact) need = 1 << 20;
        else { int cg = 0, cge = 0;
#pragma unroll
            for (int j = 0; j < 64; ++j) { cg += (u[j] > thr) ? 1 : 0; cge += (u[j] >= thr) ? 1 : 0; }
            need = (wave_isum(cge) == 256) ? (1 << 20) : 256 - wave_isum(cg); }
    }
    unsigned wlo = 0u, whi = 0u;
    if (need >= (1 << 20)) {
#pragma unroll
        for (int j = 0; j < 64; ++j) { const u64 ge = __ballot(u[j] >= thr); const unsigned glo = (unsigned)ge, ghi = (unsigned)(ge >> 32);
            asm volatile("s_nop 1\n\tv_writelane_b32 %0, %2, %4\n\tv_writelane_b32 %1, %3, %4" : "+v"(wlo), "+v"(whi) : "s"(glo), "s"(ghi), "i"(j)); }
    } else {
#pragma unroll
        for (int j = 0; j < 64; ++j) {
            const u64 gt = __ballot(u[j] > thr);
            u64 eq = __ballot(u[j] == thr);
            int c = __popcll(eq);
            while (c > need) { eq &= ~(1ull << (63 - __clzll(eq))); --c; }
            need -= c;
            const u64 w = gt | eq;
            wlo = (lane == j) ? (unsigned)w : wlo; whi = (lane == j) ? (unsigned)(w >> 32) : whi;
        }
    }
    ((GAS u64*)maskrow)[lane] = ((u64)whi << 32) | wlo;
}

template <int DV, class Valid>
__device__ __forceinline__ void naive_attn(const u16* qp, const u16* Kb, int kp, const u16* Vb, int vp, int s_lo, int s_hi, Valid valid, LAS float* pbuf, int lane, float (&o)[DV / 64], float& inv) {
    float q[64];
#pragma unroll
    for (int c = 0; c < 8; ++c) unpack8(*(const GAS u32x4*)(qp + c * 8), q + c * 8);
    const int base = s_lo & ~63;
    float mx = -INFINITY;
    for (int s0 = base; s0 <= s_hi; s0 += 64) {
        const int s = s0 + lane; float sc = -INFINITY;
        if (s >= s_lo && s <= s_hi && valid(s)) {
            const u32x4* kr = (const u32x4*)(Kb + (size_t)s * kp); sc = 0.f;
#pragma unroll
            for (int c = 0; c < 8; ++c) { float kf[8]; unpack8(kr[c], kf);
#pragma unroll
                for (int i = 0; i < 8; ++i) sc += q[c * 8 + i] * kf[i]; }
        }
        pbuf[s - base] = sc; mx = fmaxf(mx, sc);
    }
    mx = wave_max(mx);
#pragma unroll
    for (int i = 0; i < DV / 64; ++i) o[i] = 0.f;
    inv = 0.f;
    if (mx == -INFINITY) return;
    float sum = 0.f; u64 anym = 0ull;
    for (int s0 = base; s0 <= s_hi; s0 += 64) {
        const float p = __builtin_amdgcn_exp2f(pbuf[s0 - base + lane] - mx);
        pbuf[s0 - base + lane] = p; sum += p;
        if (__ballot(p > 0.f)) anym |= 1ull << ((s0 - base) >> 6);
    }
    sum = wave_sum(sum); inv = 1.0f / sum;
    const int nch = ((s_hi - base) >> 6) + 1;
    for (int ch = 0; ch < nch; ++ch) {
        if (!((anym >> ch) & 1ull)) continue;
        const LAS float* pp = pbuf + ch * 64; const u16* vr = Vb + (size_t)(base + ch * 64) * vp + lane;
#pragma unroll 8
        for (int i = 0; i < 64; ++i) {
            const float p = pp[i];
#pragma unroll
            for (int j = 0; j < DV / 64; ++j) o[j] += p * h2f(vr[(size_t)i * vp + 64 * j]);
        }
    }
#pragma unroll
    for (int i = 0; i < DV / 64; ++i) o[i] *= inv;
}

__device__ __forceinline__ void idx_unit(const Frame& F, int b, int qb8) {
    typedef float f32x16_ __attribute__((ext_vector_type(16)));
    const int lane = F.lane, wave = F.wave, r32 = lane & 31, hi = lane >> 5;
    unsigned char* ws = F.ws;
    const u16* Pb = (const u16*)(ws + WS_P) + (size_t)b * T * EVEN_N;
    u64* MASK = (u64*)(ws + WS_MASK) + (size_t)(b * T) * 64;
    const u16* KIF = (const u16*)(ws + WS_KIF);
    const int t0 = qb8 * 8;
    if (t0 + 7 < 256) {
        const int t = t0 + wave, w = lane; u64 v;
        if (64 * w + 63 <= t) v = ~0ull; else if (64 * w > t) v = 0ull; else v = (1ull << (t - 64 * w + 1)) - 1ull;
        ((GAS u64*)MASK)[(size_t)t * 64 + w] = v; return;
    }
    LAS unsigned* ub = (LAS unsigned*)F.lds;
    half8 qa[4];
    { const u16* qp = Pb + (size_t)(t0 + (r32 >> 2)) * EVEN_N + C_QI + (r32 & 3) * 64 + hi * 8;
#pragma unroll
      for (int ks = 0; ks < 4; ++ks) qa[ks] = *(const GAS half8*)(qp + ks * 16); }
    float wq[4][4];
#pragma unroll
    for (int i = 0; i < 4; ++i) { const u32x2 w2 = *(const GAS u32x2*)(Pb + (size_t)(t0 + 2 * i + hi) * EVEN_N + C_WI);
        wq[i][0] = h2f(w2.x & 0xffffu); wq[i][1] = h2f(w2.x >> 16); wq[i][2] = h2f(w2.y & 0xffffu); wq[i][3] = h2f(w2.y >> 16); }
    const int nt32 = ((t0 + 7) >> 5) + 1;
    for (int kt0 = wave; kt0 < nt32; kt0 += 64) {
        half8 kb[8][4];
#pragma unroll
        for (int u = 0; u < 8; ++u) { const int kt = (kt0 + 8 * u < nt32) ? kt0 + 8 * u : kt0;
            const u16* kp = KIF + ((size_t)(b * (T / 32) + kt) * 8 * 32 + lane) * 8;
#pragma unroll
            for (int ks = 0; ks < 4; ++ks) kb[u][ks] = *(const GAS half8*)(kp + (size_t)ks * 64 * 8); }
#pragma unroll
        for (int u = 0; u < 8; ++u) {
            const int kt = kt0 + 8 * u;
            if (kt < nt32) {
                f32x16_ c = {0.f, 0.f, 0.f, 0.f, 0.f, 0.f, 0.f, 0.f, 0.f, 0.f, 0.f, 0.f, 0.f, 0.f, 0.f, 0.f};
#pragma unroll
                for (int ks = 0; ks < 4; ++ks) c = __builtin_amdgcn_mfma_f32_32x32x16_f16(qa[ks], kb[u][ks], c, 0, 0, 0);
#pragma unroll
                for (int i = 0; i < 4; ++i) {
                    const float sc = wq[i][0] * fmaxf(c[4 * i], 0.f) + wq[i][1] * fmaxf(c[4 * i + 1], 0.f) + wq[i][2] * fmaxf(c[4 * i + 2], 0.f) + wq[i][3] * fmaxf(c[4 * i + 3], 0.f);
                    ub[(2 * i + hi) * 4096 + kt * 32 + r32] = sortable(sc);
                }
            }
        }
    }
    __syncthreads();
    select_row(ub + wave * 4096, t0 + wave, MASK + (size_t)(t0 + wave) * 64, lane, (LAS unsigned*)(F.lds + WSCR_OFF + wave * 1024));
    __syncthreads();
}

__device__ __forceinline__ void pre_phase(const Frame& F, int layer) {
    const ArgsP ap = F.a; unsigned char* ws = F.ws; const int e = layer >> 1;
    const u16* P = (const u16*)(ws + WS_P);
    const int gtid = F.bid * 512 + F.tid, GT = F.G * 512;
    u16* AC = (u16*)(ws + WS_AC);
    for (int i = gtid; i < 2 * 4 * 2 * 256 * 256; i += GT) {
        const int ch = i & 255, n = (i >> 8) & 255, g = (i >> 16) & 1, b = (i >> 17) & 3, kv = i >> 19;
        const int l = ch >> 3, d0 = (ch & 7) * 8;
        u32x4 w = (u32x4){0u, 0u, 0u, 0u};
        if (n < 255) {
            float f[8]; unpack8(*(const GAS u32x4*)(P + (size_t)(b * T + 16 * n + l) * EVEN_N + C_KC + kv * 128 + g * 64 + d0), f);
            const float* pe = G(ap->even_pe) + ((size_t)(e * 2 + kv) * 32 + l) * 64 + d0;
#pragma unroll
            for (int j = 0; j < 8; ++j) f[j] += pe[j];
            w.x = pkh(f[0], f[1]); w.y = pkh(f[2], f[3]); w.z = pkh(f[4], f[5]); w.w = pkh(f[6], f[7]);
        }
        *(GAS u32x4*)(AC + (size_t)i * 8) = w;
    }
    __syncthreads();
    if (F.G == 256) { for (int i = 0; i < 8; ++i) idx_unit(F, i >> 1, (i & 1) ? 511 - F.bid : F.bid); }
}

typedef float f32x16 __attribute__((ext_vector_type(16)));
typedef short v4i16 __attribute__((ext_vector_type(4)));
constexpr int A_KB = 0, A_VB = 32768, A_AUX = 65536;
constexpr float NEG_BIG = -1.0e30f;
__device__ __forceinline__ constexpr int crow(int r, int hi) { return (r & 3) + 8 * (r >> 2) + 4 * hi; }

template <int KD> __device__ __forceinline__ int kswz(int row, int chunk) { return (KD == 64) ? (chunk ^ ((row >> 1) & 7)) : (chunk ^ (row & 15)); }
template <int KD> __device__ __forceinline__ void stage_load_k(u32x4 (&kr)[KD / 64], const u16* Kg, int pitch, int tid) {
#pragma unroll
    for (int i = 0; i < KD / 64; ++i) { const int p = tid + 512 * i, row = p / (KD / 8), ch = p % (KD / 8);
        kr[i] = *(const GAS u32x4*)(Kg + (size_t)row * pitch + ch * 8); }
}
template <int KD> __device__ __forceinline__ void stage_write_k(LAS unsigned char* kb, const u32x4 (&kr)[KD / 64], int tid) {
#pragma unroll
    for (int i = 0; i < KD / 64; ++i) { const int p = tid + 512 * i, row = p / (KD / 8), ch = p % (KD / 8);
        *(LAS u32x4*)(kb + row * (KD * 2) + kswz<KD>(row, ch) * 16) = kr[i]; }
}
template <int DV> __device__ __forceinline__ void stage_load_v(u32x4 (&vr)[DV / 64], const u16* Vg, int pitch, int wave, int lane) {
#pragma unroll
    for (int i = 0; i < DV / 64; ++i) { const int p = wave + 8 * i, dh = p >> 2, rg = p & 3;
        vr[i] = *(const GAS u32x4*)(Vg + (size_t)(16 * rg + (lane >> 2)) * pitch + dh * 32 + (lane & 3) * 8); }
}
template <int DV> __device__ __forceinline__ void stage_write_v(LAS unsigned char* vb, const u32x4 (&vr)[DV / 64], int wave, int lane) {
#pragma unroll
    for (int i = 0; i < DV / 64; ++i) *(LAS u32x4*)(vb + (wave + 8 * i) * 1024 + lane * 16) = vr[i];
}
template <int KD, int VAR = 0> __device__ __forceinline__ void qk_tile(f32x16& p0, f32x16& p1, const LAS unsigned char* kbuf, int chunk0, int r32, int hi, const half8 (&qr)[4], const f32x16& z) {
    const LAS unsigned char* kb = kbuf + r32 * (KD * 2);
    half8 b0[4], b1[4];
#pragma unroll
    for (int d0 = 0; d0 < 4; ++d0) {
        const int off = kswz<KD>(r32, chunk0 + 2 * d0 + hi) * 16;
        b0[d0] = *(const LAS half8*)(kb + off); b1[d0] = *(const LAS half8*)(kb + 32 * (KD * 2) + off);
    }
    __builtin_amdgcn_sched_barrier(0);
    if (VAR == 3) { p0 = z; p1 = z; p0[0] = (float)b0[0][0] + (float)b1[1][0] + (float)b0[2][0] + (float)b1[3][0]; p1[0] = (float)b1[0][0] + (float)b0[1][0] + (float)b1[2][0] + (float)b0[3][0]; return; }
#pragma unroll
    for (int d0 = 0; d0 < 4; ++d0) {
        p0 = __builtin_amdgcn_mfma_f32_32x32x16_f16(b0[d0], qr[d0], d0 ? p0 : z, 0, 0, 0);
        p1 = __builtin_amdgcn_mfma_f32_32x32x16_f16(b1[d0], qr[d0], d0 ? p1 : z, 0, 0, 0);
    }
}
__device__ __forceinline__ float swap_max(float m) { auto rr = __builtin_amdgcn_permlane32_swap(__float_as_uint(m), __float_as_uint(m), false, false); return fmaxf(__uint_as_float(rr[0]), __uint_as_float(rr[1])); }
__device__ __forceinline__ float swap_sum(float m) { auto rr = __builtin_amdgcn_permlane32_swap(__float_as_uint(m), __float_as_uint(m), false, false); return __uint_as_float(rr[0]) + __uint_as_float(rr[1]); }
__device__ __forceinline__ float max3f(float a, float b, float c) { float r; asm("v_max3_f32 %0, %1, %2, %3" : "=v"(r) : "v"(a), "v"(b), "v"(c)); return r; }
typedef float f32x2 __attribute__((ext_vector_type(2)));
template <int DV> __device__ __forceinline__ void softmax_tile(f32x16& p0, f32x16& p1, float& m, int& started, f32x16& negm, float& l, f32x16 (&o)[DV / 32], LAS float* wsf, int r32, int hi, u32x4 (&pw)[4]) {
    asm volatile("s_nop 7\n\ts_nop 7\n\ts_nop 7" : "+v"(p0), "+v"(p1));
    float a = max3f(p0[0], p0[1], p1[0]), b = max3f(p0[2], p0[3], p1[1]); a = max3f(a, p1[2], p1[3]);
#pragma unroll
    for (int r = 4; r < 16; r += 4) { a = max3f(a, p0[r], p0[r + 1]); b = max3f(b, p0[r + 2], p0[r + 3]); a = max3f(a, p1[r], p1[r + 1]); b = max3f(b, p1[r + 2], p1[r + 3]); }
    const float rm = swap_max(max3f(a, b, b));
    const bool first = (started == 0) && (rm > -INFINITY);
    if (__any(first || rm > 8.0f)) {
        float delta = 0.f, f = 1.f;
        if (first) { delta = rm; started = 1; }
        else if (started && rm > 8.0f) { delta = rm; f = __builtin_amdgcn_exp2f(-rm); }
        m += delta; l *= f;
#pragma unroll
        for (int r = 0; r < 16; ++r) { p0[r] -= delta; p1[r] -= delta; negm[r] = -m; }
        if (hi == 0) wsf[r32] = f;
        asm volatile("s_waitcnt lgkmcnt(0)" ::: "memory");
#pragma unroll
        for (int r = 0; r < 16; ++r) { const float fr_ = wsf[crow(r, hi)];
#pragma unroll
            for (int d0 = 0; d0 < DV / 32; ++d0) o[d0][r] *= fr_; }
    }
    f32x2 s2 = {0.f, 0.f};
#pragma unroll
    for (int r = 0; r < 16; r += 2) {
        p0[r] = __builtin_amdgcn_exp2f(p0[r]); p0[r + 1] = __builtin_amdgcn_exp2f(p0[r + 1]); p1[r] = __builtin_amdgcn_exp2f(p1[r]); p1[r + 1] = __builtin_amdgcn_exp2f(p1[r + 1]);
        s2 += (f32x2){p0[r], p0[r + 1]}; s2 += (f32x2){p1[r], p1[r + 1]};
    }
    l += s2.x + s2.y;
    pw[0] = (u32x4){pkh(p0[0], p0[1]), pkh(p0[2], p0[3]), pkh(p0[4], p0[5]), pkh(p0[6], p0[7])};
    pw[1] = (u32x4){pkh(p0[8], p0[9]), pkh(p0[10], p0[11]), pkh(p0[12], p0[13]), pkh(p0[14], p0[15])};
    pw[2] = (u32x4){pkh(p1[0], p1[1]), pkh(p1[2], p1[3]), pkh(p1[4], p1[5]), pkh(p1[6], p1[7])};
    pw[3] = (u32x4){pkh(p1[8], p1[9]), pkh(p1[10], p1[11]), pkh(p1[12], p1[13]), pkh(p1[14], p1[15])};
}
__device__ __forceinline__ v4i16 vtr(const LAS unsigned char* p) { return __builtin_amdgcn_ds_read_tr16_b64_v4i16((LAS v4i16*)p); }
struct VFrag { v4i16 lo[2][2], hh[2][2]; };
__device__ __forceinline__ void v_group_load(VFrag& f, const LAS unsigned char* vb, int g) {
    const int dp = g >> 1, kh = g & 1;
#pragma unroll
    for (int e = 0; e < 2; ++e)
#pragma unroll
        for (int k2 = 0; k2 < 2; ++k2) { const int ks = 2 * kh + k2; f.lo[e][k2] = vtr(vb + (2 * dp + e) * 4096 + ks * 1024); f.hh[e][k2] = vtr(vb + (2 * dp + e) * 4096 + ks * 1024 + 512); }
}
template <int DV> __device__ __forceinline__ void v_group_mma(f32x16 (&o)[DV / 32], const VFrag& f, const u32x4 (&pw)[4], int g) {
    const int dp = g >> 1, kh = g & 1;
#pragma unroll
    for (int k2 = 0; k2 < 2; ++k2)
#pragma unroll
        for (int e = 0; e < 2; ++e) {
            const s16x8 vf = {f.lo[e][k2][0], f.lo[e][k2][1], f.lo[e][k2][2], f.lo[e][k2][3], f.hh[e][k2][0], f.hh[e][k2][1], f.hh[e][k2][2], f.hh[e][k2][3]};
            o[2 * dp + e] = __builtin_amdgcn_mfma_f32_32x32x16_f16(__builtin_bit_cast(half8, pw[2 * kh + k2]), __builtin_bit_cast(half8, vf), o[2 * dp + e], 0, 0, 0);
        }
}
template <int DV> __device__ __forceinline__ void pv_tile(f32x16 (&o)[DV / 32], const LAS unsigned char* vb, const u32x4 (&pw)[4], VFrag& fA) {
    VFrag fB;
    v_group_load(fB, vb, 1); __builtin_amdgcn_sched_barrier(0);
    v_group_mma<DV>(o, fA, pw, 0); __builtin_amdgcn_sched_barrier(0);
    if (DV == 128) {
        v_group_load(fA, vb, 2); __builtin_amdgcn_sched_barrier(0);
        v_group_mma<DV>(o, fB, pw, 1); __builtin_amdgcn_sched_barrier(0);
        v_group_load(fB, vb, 3); __builtin_amdgcn_sched_barrier(0);
        v_group_mma<DV>(o, fA, pw, 2); __builtin_amdgcn_sched_barrier(0);
        v_group_mma<DV>(o, fB, pw, 3); __builtin_amdgcn_sched_barrier(0);
    } else {
        v_group_mma<DV>(o, fB, pw, 1); __builtin_amdgcn_sched_barrier(0);
    }
}
__device__ __forceinline__ int vtr_lane_off(int lane) { const int hi = lane >> 5; return ((lane >> 4) & 1) * 32 + (lane & 3) * 8 + (4 * hi + ((lane & 15) >> 2)) * 64; }
__device__ __forceinline__ void finalize_rows(float l, float gate, LAS float* wsf, int r32, int hi, float (&rli)[16]) {
    l = swap_sum(l);
    if (hi == 0) wsf[32 + r32] = gate / fmaxf(l, 1e-30f);
    asm volatile("s_waitcnt lgkmcnt(0)" ::: "memory");
#pragma unroll
    for (int r = 0; r < 16; ++r) rli[r] = wsf[32 + crow(r, hi)];
    asm volatile("s_waitcnt lgkmcnt(0)" ::: "memory");
}

template <int KD, int DV, int MODE, int VAR = 0>
__device__ __forceinline__ void attn_range_loop(const Frame& F, const u16* Kg, int kpitch, int kchunk0, const u16* Vg, int vpitch, u64 tiles, int kmax, int kmin, u64 rowsel, const LAS u64* ml,
                                                const half8 (&qr)[4], f32x16 (&o)[DV / 32], float& m, float& l) {
    const int lane = F.lane, wave = F.wave, r32 = lane & 31, hi = lane >> 5;
    LAS float* wsf = (LAS float*)(F.lds + WSCR_OFF + wave * 1024);
    m = 0.f; l = 0.f; int started = 0;
    f32x16 negm = {0.f, 0.f, 0.f, 0.f, 0.f, 0.f, 0.f, 0.f, 0.f, 0.f, 0.f, 0.f, 0.f, 0.f, 0.f, 0.f};
    if (tiles == 0ull) return;
    u32x4 krA[KD / 64], vrA[DV / 64], krB[KD / 64], vrB[DV / 64];
    int Tlast;
    { const int T0 = __builtin_ctzll(tiles); Tlast = 63 - __builtin_clzll(tiles);
      stage_load_k<KD>(krA, Kg + (size_t)T0 * 64 * kpitch, kpitch, F.tid); stage_load_v<DV>(vrA, Vg + (size_t)T0 * 64 * vpitch, vpitch, wave, lane);
      stage_write_k<KD>(F.lds + A_KB, krA, F.tid); stage_write_v<DV>(F.lds + A_VB, vrA, wave, lane);
      const u64 t1 = tiles & (tiles - 1ull);
      const int T1 = t1 ? __builtin_ctzll(t1) : Tlast;
      stage_load_k<KD>(krA, Kg + (size_t)T1 * 64 * kpitch, kpitch, F.tid); stage_load_v<DV>(vrA, Vg + (size_t)T1 * 64 * vpitch, vpitch, wave, lane); }
    __syncthreads();
    const int voff = vtr_lane_off(lane);
    int cur = 0;
#define ATTN_STEP(RNk, RNv, RFk, RFv) { \
        const int Tt = __builtin_ctzll(tiles); tiles &= tiles - 1ull; \
        const bool more = tiles != 0ull; \
        { const u64 t2 = tiles & (tiles - 1ull); \
          const int T2 = t2 ? __builtin_ctzll(t2) : Tlast; \
          stage_load_k<KD>(RFk, Kg + (size_t)T2 * 64 * kpitch, kpitch, F.tid); stage_load_v<DV>(RFv, Vg + (size_t)T2 * 64 * vpitch, vpitch, wave, lane); } \
        f32x16 p0, p1; u32x4 pw[4]; \
        qk_tile<KD>(p0, p1, F.lds + A_KB + cur * 16384, kchunk0, r32, hi, qr, negm); \
        VFrag vf0; if (DV == 64) v_group_load(vf0, F.lds + A_VB + cur * 16384 + voff, 0);     \
        if (VAR == 2) { } else if (MODE == 1) { const u64 mk = ml[Tt * 32 + r32]; const int mlo = (int)((unsigned)mk >> (4 * hi)), mhi = (int)((unsigned)(mk >> 32) >> (4 * hi)); \
            _Pragma("unroll") for (int r = 0; r < 16; ++r) {     \
                const unsigned s0 = (unsigned)__builtin_amdgcn_sbfe(mlo, crow(r, 0), 1), s1 = (unsigned)__builtin_amdgcn_sbfe(mhi, crow(r, 0), 1); \
                p0[r] = __uint_as_float((__float_as_uint(p0[r]) & s0) | (0xff800000u & ~s0)); p1[r] = __uint_as_float((__float_as_uint(p1[r]) & s1) | (0xff800000u & ~s1)); } } \
        else { const int eff = ((rowsel >> Tt) & 1ull) ? kmax : -1; const int kv0 = 64 * Tt + 4 * hi; \
            if (__any(64 * Tt + 63 > eff)) { const int dd = eff - kv0; \
                _Pragma("unroll") for (int r = 0; r < 16; ++r) { p0[r] = (dd >= crow(r, 0)) ? p0[r] : -INFINITY; p1[r] = (dd >= crow(r, 0) + 32) ? p1[r] : -INFINITY; } } \
            if (__any(64 * Tt < kmin)) { const int dd = kmin - kv0; \
                _Pragma("unroll") for (int r = 0; r < 16; ++r) { p0[r] = (crow(r, 0) >= dd) ? p0[r] : -INFINITY; p1[r] = (crow(r, 0) + 32 >= dd) ? p1[r] : -INFINITY; } } } \
        softmax_tile<DV>(p0, p1, m, started, negm, l, o, wsf, r32, hi, pw); \
        if (DV != 64) v_group_load(vf0, F.lds + A_VB + cur * 16384 + voff, 0); \
        pv_tile<DV>(o, F.lds + A_VB + cur * 16384 + voff, pw, vf0); \
        stage_write_k<KD>(F.lds + A_KB + (cur ^ 1) * 16384, RNk, F.tid); stage_write_v<DV>(F.lds + A_VB + (cur ^ 1) * 16384, RNv, wave, lane); \
        __syncthreads(); cur ^= 1; \
        if (!more) break; }
    for (;;) {
        ATTN_STEP(krA, vrA, krB, vrB)
        ATTN_STEP(krB, vrB, krA, vrA)
    }
#undef ATTN_STEP
}

__device__ __forceinline__ void hs_glds16(const void* gsrc, unsigned lds_dst) { unsigned keep;
    asm volatile("s_mov_b32 %0, m0\n\ts_mov_b32 m0, %2\n\ts_nop 0\n\tglobal_load_lds_dwordx4 %1, off\n\ts_mov_b32 m0, %0" : "=&s"(keep) : "v"(gsrc), "s"(lds_dst) : "memory"); }

template <int MODE>
__device__ __forceinline__ void attn_dma_loop(const Frame& F, const u16* Kg, int kpitch, const u16* Vg, int vpitch, u64 tiles, int kmax, int kmin, u64 rowsel, const LAS u64* ml,
                                              const half8 (&qr)[4], f32x16 (&o)[2], float& m, float& l) {
    const int lane = F.lane, wave = F.wave, r32 = lane & 31, hi = lane >> 5;
    LAS float* wsf = (LAS float*)(F.lds + WSCR_OFF + wave * 1024);
    m = 0.f; l = 0.f; int started = 0;
    f32x16 negm = {0.f, 0.f, 0.f, 0.f, 0.f, 0.f, 0.f, 0.f, 0.f, 0.f, 0.f, 0.f, 0.f, 0.f, 0.f, 0.f};
    if (tiles == 0ull) return;
    constexpr int SL = 8192, VB = 3 * SL;
    const int lds0 = (int)(unsigned)(size_t)F.lds;
    const int krow = 8 * wave + (lane >> 3), kch = (lane & 7) ^ ((krow >> 1) & 7);
    const unsigned kso = (unsigned)(krow * kpitch + kch * 8) * 2u;
    const unsigned vso = (unsigned)((16 * (wave & 3) + (lane >> 2)) * vpitch + (wave >> 2) * 32 + (lane & 3) * 8) * 2u;
#define AD_DMA(T_, slot_) { hs_glds16((const char*)Kg + (size_t)(T_) * 128 * kpitch + kso, (unsigned)__builtin_amdgcn_readfirstlane(lds0 + (slot_) + wave * 1024)); \
                            hs_glds16((const char*)Vg + (size_t)(T_) * 128 * vpitch + vso, (unsigned)__builtin_amdgcn_readfirstlane(lds0 + VB + (slot_) + wave * 1024)); }
    int Tlast;
    { const int T0 = __builtin_ctzll(tiles); Tlast = 63 - __builtin_clzll(tiles);
      AD_DMA(T0, 0)
      const u64 t1 = tiles & (tiles - 1ull);
      const int T1 = t1 ? __builtin_ctzll(t1) : Tlast;
      AD_DMA(T1, SL) }
    asm volatile("s_waitcnt vmcnt(2) lgkmcnt(0)\n\ts_barrier" ::: "memory");
    const int voff = vtr_lane_off(lane);
    int sc = 0, sn2 = 2 * SL;
    for (;;) {
        sc = __builtin_amdgcn_readfirstlane(sc); sn2 = __builtin_amdgcn_readfirstlane(sn2);
        const int Tt = __builtin_ctzll(tiles); tiles &= tiles - 1ull;
        const bool more = tiles != 0ull;
        { const u64 t2 = tiles & (tiles - 1ull);
          const int T2 = t2 ? __builtin_ctzll(t2) : Tlast;
          AD_DMA(T2, sn2) }
        bool active = true;
        if (MODE == 0) active = __any(((rowsel >> Tt) & 1ull) != 0ull && kmax >= 64 * Tt && kmin <= 64 * Tt + 63);
        if (active) {
        f32x16 p0, p1; u32x4 pw[4];
        qk_tile<64>(p0, p1, F.lds + sc, 0, r32, hi, qr, negm);
        VFrag vf0; v_group_load(vf0, F.lds + VB + sc + voff, 0);
        if (MODE == 1) { const u64 mk = ml[Tt * 32 + r32]; const int mlo = (int)((unsigned)mk >> (4 * hi)), mhi = (int)((unsigned)(mk >> 32) >> (4 * hi));
#pragma unroll
            for (int r = 0; r < 16; ++r) {
                const unsigned s0 = (unsigned)__builtin_amdgcn_sbfe(mlo, crow(r, 0), 1), s1 = (unsigned)__builtin_amdgcn_sbfe(mhi, crow(r, 0), 1);
                p0[r] = __uint_as_float((__float_as_uint(p0[r]) & s0) | (0xff800000u & ~s0)); p1[r] = __uint_as_float((__float_as_uint(p1[r]) & s1) | (0xff800000u & ~s1)); } }
        else { const int eff = ((rowsel >> Tt) & 1ull) ? kmax : -1; const int kv0 = 64 * Tt + 4 * hi;
            if (__any(64 * Tt + 63 > eff)) { const int dd = eff - kv0;
#pragma unroll
                for (int r = 0; r < 16; ++r) { p0[r] = (dd >= crow(r, 0)) ? p0[r] : -INFINITY; p1[r] = (dd >= crow(r, 0) + 32) ? p1[r] : -INFINITY; } }
            if (__any(64 * Tt < kmin)) { const int dd = kmin - kv0;
#pragma unroll
                for (int r = 0; r < 16; ++r) { p0[r] = (crow(r, 0) >= dd) ? p0[r] : -INFINITY; p1[r] = (crow(r, 0) + 32 >= dd) ? p1[r] : -INFINITY; } } }
        softmax_tile<64>(p0, p1, m, started, negm, l, o, wsf, r32, hi, pw);
        pv_tile<64>(o, F.lds + VB + sc + voff, pw, vf0);
        }
        asm volatile("s_waitcnt vmcnt(2) lgkmcnt(0)\n\ts_barrier" ::: "memory");
        sn2 = sc; sc = (sc == 2 * SL) ? 0 : sc + SL;
        if (!more) break;
    }
    asm volatile("s_waitcnt vmcnt(0)" ::: "memory");
    __syncthreads();
#undef AD_DMA
}

#define HS_SBAR() __builtin_amdgcn_sched_barrier(0)
#define HS_PIN(x) asm volatile("" : "+v"(x))
#define HS_WAIT_BAR(N) asm volatile("s_waitcnt vmcnt(" #N ") lgkmcnt(0)\n\ts_barrier" ::: "memory")
struct HsVf { v4i16 lo, hh; };
__device__ __forceinline__ void diff_loop_hs(const Frame& F, const u16* Kg, const u16* Vg, int NT, int tq, int chunk0, const half8 (&qr)[4], f32x16 (&o)[4], float& l_out) {
    const int lane = F.lane, wave = F.wave, r32 = lane & 31, hi = lane >> 5;
    LAS float* wsf = (LAS float*)(F.lds + WSCR_OFF + wave * 1024);
    constexpr int SLOT = 16384, VB = 3 * SLOT;
    constexpr size_t TSTEP = (size_t)64 * ODD_N * 2;
    unsigned kso[2], vso[2];
#pragma unroll
    for (int i = 0; i < 2; ++i) { const int p = wave + 8 * i, row = 4 * p + (lane >> 4), c = (lane & 15) ^ (row & 15); kso[i] = (unsigned)(row * ODD_N + c * 8) * 2u; }
#pragma unroll
    for (int i = 0; i < 2; ++i) { const int p = wave + 8 * i, dh = p >> 2, rg = p & 3; vso[i] = (unsigned)((16 * rg + (lane >> 2)) * ODD_N + dh * 32 + (lane & 3) * 8) * 2u; }
#define HS_DMA_K(t_, slot_) { const int tt_ = ((t_) < NT) ? (t_) : NT - 1; const char* g_ = (const char*)Kg + (size_t)tt_ * TSTEP; \
        _Pragma("unroll") for (int i_ = 0; i_ < 2; ++i_) hs_glds16(g_ + kso[i_], (unsigned)__builtin_amdgcn_readfirstlane(lds0 + (slot_) + (wave + 8 * i_) * 1024)); }
#define HS_DMA_V(t_, slot_) { const int tt_ = ((t_) < NT) ? (t_) : NT - 1; const char* g_ = (const char*)Vg + (size_t)tt_ * TSTEP; \
        _Pragma("unroll") for (int i_ = 0; i_ < 2; ++i_) hs_glds16(g_ + vso[i_], (unsigned)__builtin_amdgcn_readfirstlane(lds0 + VB + (slot_) + (wave + 8 * i_) * 1024)); }
    const int lds0 = (int)(unsigned)(size_t)F.lds;
    int kfo[4];
#pragma unroll
    for (int d0 = 0; d0 < 4; ++d0) kfo[d0] = r32 * 256 + (((chunk0 + 2 * d0 + hi) ^ (r32 & 15)) * 16);
    const int voff = vtr_lane_off(lane);
    HS_DMA_K(0, 0) HS_DMA_V(0, 0) HS_DMA_K(1, SLOT) HS_DMA_K(2, 2 * SLOT)
    f32x16 negm = {0.f, 0.f, 0.f, 0.f, 0.f, 0.f, 0.f, 0.f, 0.f, 0.f, 0.f, 0.f, 0.f, 0.f, 0.f, 0.f};
    f32x16 P[2]; half8 kf[8]; u32x4 pw[4]; HsVf vf[4];
    float m = 0.f, l = 0.f; bool resc = false;
#define HS_KLD(j_, slot_) kf[j_] = *(const LAS half8*)(F.lds + (slot_) + kfo[(j_) >> 1] + ((j_) & 1) * 8192)
#define HS_MASK(t_) { const int dd_ = tq - (64 * (t_) + 4 * hi); \
        _Pragma("unroll") for (int r = 0; r < 16; ++r) { P[0][r] = (dd_ >= crow(r, 0)) ? P[0][r] : -INFINITY; P[1][r] = (dd_ >= crow(r, 0) + 32) ? P[1][r] : -INFINITY; } }
#define HS_MX3(a, b, c) __builtin_fmaxf(__builtin_fmaxf((a), (b)), (c))
#define HS_ROWMAX(rm_) { float a_ = HS_MX3(P[0][0], P[0][1], P[1][0]), b_ = HS_MX3(P[0][2], P[0][3], P[1][1]); a_ = HS_MX3(a_, P[1][2], P[1][3]); \
        _Pragma("unroll") for (int r = 4; r < 16; r += 4) { a_ = HS_MX3(a_, P[0][r], P[0][r + 1]); b_ = HS_MX3(b_, P[0][r + 2], P[0][r + 3]); a_ = HS_MX3(a_, P[1][r], P[1][r + 1]); b_ = HS_MX3(b_, P[1][r + 2], P[1][r + 3]); } \
        rm_ = swap_max(__builtin_fmaxf(a_, b_)); }
#define HS_PE(e_) P[(e_) >> 4][(e_) & 15]
    HS_WAIT_BAR(6);
#pragma unroll
    for (int j = 0; j < 8; ++j) HS_KLD(j, 0);
#pragma unroll
    for (int d0 = 0; d0 < 4; ++d0) {
        P[0] = __builtin_amdgcn_mfma_f32_32x32x16_f16(kf[2 * d0], qr[d0], d0 ? P[0] : negm, 0, 0, 0);
        P[1] = __builtin_amdgcn_mfma_f32_32x32x16_f16(kf[2 * d0 + 1], qr[d0], d0 ? P[1] : negm, 0, 0, 0); }
    if (NT == 2) HS_MASK(0)
    { float rm; HS_ROWMAX(rm) m = rm;
#pragma unroll
      for (int r = 0; r < 16; ++r) { P[0][r] -= rm; P[1][r] -= rm; negm[r] = -m; }
      float sacc = 0.f;
#pragma unroll
      for (int e = 0; e < 32; ++e) { HS_PE(e) = __builtin_amdgcn_exp2f(HS_PE(e)); sacc += HS_PE(e); }
      l = sacc;
#pragma unroll
      for (int c = 0; c < 16; ++c) pw[c >> 2][c & 3] = pkh(HS_PE(2 * c), HS_PE(2 * c + 1)); }
    HS_WAIT_BAR(2);
    HS_DMA_K(3, 0) HS_DMA_V(1, SLOT)
#pragma unroll
    for (int j = 0; j < 8; ++j) HS_KLD(j, SLOT);
#pragma unroll
    for (int d0 = 0; d0 < 4; ++d0) {
        P[0] = __builtin_amdgcn_mfma_f32_32x32x16_f16(kf[2 * d0], qr[d0], d0 ? P[0] : negm, 0, 0, 0);
        P[1] = __builtin_amdgcn_mfma_f32_32x32x16_f16(kf[2 * d0 + 1], qr[d0], d0 ? P[1] : negm, 0, 0, 0); }
    HS_WAIT_BAR(4);
    int sp = 0, sc = SLOT, sn = 2 * SLOT;
    for (int t = 1; t < NT; ++t) {
        const bool last = (t == NT - 1);
        sp = __builtin_amdgcn_readfirstlane(sp); sc = __builtin_amdgcn_readfirstlane(sc); sn = __builtin_amdgcn_readfirstlane(sn);
        HS_SBAR();
        HS_DMA_K(t + 3, sc) HS_DMA_V(t + 1, sn)
        const LAS unsigned char* vb = F.lds + VB + sp + voff;
#pragma unroll
        for (int d0 = 0; d0 < 4; ++d0) { vf[d0].lo = vtr(vb + d0 * 4096); vf[d0].hh = vtr(vb + d0 * 4096 + 512); }
        HS_SBAR();
        if (t >= NT - 2) HS_MASK(t)
        { float rm; HS_ROWMAX(rm)
          resc = false;
          if (__builtin_expect(__any(rm > 8.0f), 0)) {
              const float dl = __builtin_fmaxf(rm, 0.f); m += dl;
#pragma unroll
              for (int r = 0; r < 16; ++r) { P[0][r] -= dl; P[1][r] -= dl; negm[r] = -m; }
              HS_PIN(negm);
              const float f = __builtin_amdgcn_exp2f(-dl); l *= f; if (hi == 0) wsf[r32] = f; resc = true; } }
        HS_SBAR();
        float sacc = 0.f;
#pragma unroll
        for (int g = 0; g < 16; ++g) {
            const int ks = g >> 2, d0 = g & 3;
            { const s16x8 vfr = {vf[d0].lo[0], vf[d0].lo[1], vf[d0].lo[2], vf[d0].lo[3], vf[d0].hh[0], vf[d0].hh[1], vf[d0].hh[2], vf[d0].hh[3]};
              o[d0] = __builtin_amdgcn_mfma_f32_32x32x16_f16(__builtin_bit_cast(half8, pw[ks]), __builtin_bit_cast(half8, vfr), o[d0], 0, 0, 0); }
            if (g + 4 < 16) { const int ks2 = (g + 4) >> 2; vf[d0].lo = vtr(vb + d0 * 4096 + ks2 * 1024); vf[d0].hh = vtr(vb + d0 * 4096 + ks2 * 1024 + 512); }
            if (!last && g >= 4 && g < 12) { const int q_ = g - 4; const int j = (q_ == 0) ? 0 : (q_ == 1) ? 2 : (q_ == 2) ? 1 : (q_ == 3) ? 4 : (q_ == 4) ? 3 : (q_ == 5) ? 6 : (q_ == 6) ? 5 : 7; HS_KLD(j, sn); }
            HS_PE(2 * g) = __builtin_amdgcn_exp2f(HS_PE(2 * g)); HS_PE(2 * g + 1) = __builtin_amdgcn_exp2f(HS_PE(2 * g + 1));
            if (g >= 1) { sacc += HS_PE(2 * g - 2); sacc += HS_PE(2 * g - 1); HS_PIN(sacc); }
            if (g >= 4) { const int c = g - 4; pw[c >> 2][c & 3] = pkh(HS_PE(2 * c), HS_PE(2 * c + 1)); HS_PIN(pw[c >> 2]); }
            HS_PIN(P[0]); HS_PIN(P[1]);
            HS_SBAR();
        }
        if (!last) {
            P[0] = __builtin_amdgcn_mfma_f32_32x32x16_f16(kf[0], qr[0], negm, 0, 0, 0);
            sacc += P[1][14]; sacc += P[1][15]; pw[3][0] = pkh(P[1][8], P[1][9]); pw[3][1] = pkh(P[1][10], P[1][11]); HS_PIN(sacc); HS_PIN(pw[3]); HS_SBAR();
            P[0] = __builtin_amdgcn_mfma_f32_32x32x16_f16(kf[2], qr[1], P[0], 0, 0, 0);
            pw[3][2] = pkh(P[1][12], P[1][13]); pw[3][3] = pkh(P[1][14], P[1][15]); HS_PIN(pw[3]); HS_SBAR();
            P[1] = __builtin_amdgcn_mfma_f32_32x32x16_f16(kf[1], qr[0], negm, 0, 0, 0); HS_SBAR();
            P[0] = __builtin_amdgcn_mfma_f32_32x32x16_f16(kf[4], qr[2], P[0], 0, 0, 0); HS_SBAR();
            P[1] = __builtin_amdgcn_mfma_f32_32x32x16_f16(kf[3], qr[1], P[1], 0, 0, 0); HS_SBAR();
            P[0] = __builtin_amdgcn_mfma_f32_32x32x16_f16(kf[6], qr[3], P[0], 0, 0, 0); HS_SBAR();
            P[1] = __builtin_amdgcn_mfma_f32_32x32x16_f16(kf[5], qr[2], P[1], 0, 0, 0); HS_SBAR();
            P[1] = __builtin_amdgcn_mfma_f32_32x32x16_f16(kf[7], qr[3], P[1], 0, 0, 0); HS_SBAR();
            l += sacc;
            HS_WAIT_BAR(4);
        } else {
            sacc += P[1][14]; sacc += P[1][15]; l += sacc;
            pw[3] = (u32x4){pkh(P[1][8], P[1][9]), pkh(P[1][10], P[1][11]), pkh(P[1][12], P[1][13]), pkh(P[1][14], P[1][15])};
            HS_WAIT_BAR(0);
        }
        if (resc) {
            asm volatile("s_waitcnt lgkmcnt(0)" ::: "memory");
#pragma unroll
            for (int r = 0; r < 16; ++r) { const float fr_ = wsf[crow(r, hi)];
#pragma unroll
                for (int d0 = 0; d0 < 4; ++d0) o[d0][r] *= fr_; } }
        { const int s_ = sp; sp = sc; sc = sn; sn = s_; }
    }
    { const LAS unsigned char* vb = F.lds + VB + sp + voff;
#pragma unroll
      for (int d0 = 0; d0 < 4; ++d0) { vf[d0].lo = vtr(vb + d0 * 4096); vf[d0].hh = vtr(vb + d0 * 4096 + 512); }
#pragma unroll
      for (int g = 0; g < 16; ++g) {
          const int ks = g >> 2, d0 = g & 3;
          { const s16x8 vfr = {vf[d0].lo[0], vf[d0].lo[1], vf[d0].lo[2], vf[d0].lo[3], vf[d0].hh[0], vf[d0].hh[1], vf[d0].hh[2], vf[d0].hh[3]};
            o[d0] = __builtin_amdgcn_mfma_f32_32x32x16_f16(__builtin_bit_cast(half8, pw[ks]), __builtin_bit_cast(half8, vfr), o[d0], 0, 0, 0); }
          if (g + 4 < 16) { const int ks2 = (g + 4) >> 2; vf[d0].lo = vtr(vb + d0 * 4096 + ks2 * 1024); vf[d0].hh = vtr(vb + d0 * 4096 + ks2 * 1024 + 512); }
          HS_SBAR(); } }
    l_out = l;
    asm volatile("s_waitcnt lgkmcnt(0)\n\ts_barrier" ::: "memory");
#undef HS_DMA_K
#undef HS_DMA_V
#undef HS_KLD
#undef HS_MASK
#undef HS_MX3
#undef HS_ROWMAX
#undef HS_PE
}

template <int DV> __device__ __forceinline__ void flush_stage(const LAS u16* stg, u16* Og, int lane) {
    asm volatile("s_waitcnt lgkmcnt(0)" ::: "memory");
    constexpr int CPR = DV / 8, RPI = 64 / CPR;
#pragma unroll
    for (int i = 0; i < 32 / RPI; ++i) { const int row = i * RPI + lane / CPR, ch = lane % CPR;
        const u32x4 v = *(const LAS u32x4*)(stg + row * DV + ch * 8);
        *(GAS u32x4*)(Og + (size_t)row * DM + ch * 8) = v;
        if (DV == 128 && (i & 1)) asm volatile("" ::: "memory"); }
}


#ifndef PROBE_VAR
#define PROBE_VAR -1
#endif
template <int VAR> __device__ __forceinline__ void dsa_probe_unit(const Frame& F, int b, int qb) {
    const int lane = F.lane, wave = F.wave, r32 = lane & 31, hi = lane >> 5;
    unsigned char* ws = F.ws;
    const u16* Pb = (const u16*)(ws + WS_P) + (size_t)b * T * EVEN_N;
    const u64* MASK = (const u64*)(ws + WS_MASK);
    u16* O = (u16*)(ws + 224 * MiB);
    const int t0 = qb * 32, NT = ((t0 + 31) >> 6) + 1;
    LAS u64* ml = (LAS u64*)(F.lds + A_AUX);
    LAS float* wsf = (LAS float*)(F.lds + WSCR_OFF + wave * 1024);
    for (int i = F.tid; i < NT * 32; i += 512) { const int q = i & 31, tl = i >> 5; ml[tl * 32 + q] = ((const GAS u64*)MASK)[(size_t)(b * T + t0 + q) * 64 + tl]; }
    half8 qr[4];
    { const u16* qp = Pb + (size_t)(t0 + r32) * EVEN_N + C_QA + wave * 64 + hi * 8;
#pragma unroll
      for (int d0 = 0; d0 < 4; ++d0) qr[d0] = *(const GAS half8*)(qp + d0 * 16); }
    f32x16 o[2]; float m = 0.f, l = 0.f;
#pragma unroll
    for (int d0 = 0; d0 < 2; ++d0)
#pragma unroll
        for (int r = 0; r < 16; ++r) o[d0][r] = 0.f;
    const u64 tiles = (NT >= 64) ? ~0ull : ((1ull << NT) - 1ull);
    attn_range_loop<64, 64, 1, VAR>(F, Pb + C_KA, EVEN_N, 0, Pb + C_VA, EVEN_N, tiles, 0, 0, ~0ull, ml, qr, o, m, l);
    __syncthreads();
    float rli[16]; finalize_rows(l, 1.0f, wsf, r32, hi, rli);
    LAS u16* stg = (LAS u16*)(F.lds + A_AUX + 32768 + wave * 4096);
#pragma unroll
    for (int r = 0; r < 16; ++r)
#pragma unroll
        for (int d0 = 0; d0 < 2; ++d0) stg[crow(r, hi) * 64 + d0 * 32 + r32] = (u16)(pkh(o[d0][r] * rli[r], 0.f) & 0xffffu);
    flush_stage<64>(stg, O + (size_t)(b * T + t0) * DM + wave * 64, lane);
    __syncthreads();
}

__device__ __forceinline__ void dsa_unit(const Frame& F, int b, int qb) {
    const int lane = F.lane, wave = F.wave, r32 = lane & 31, hi = lane >> 5;
    unsigned char* ws = F.ws;
    const u16* Pb = (const u16*)(ws + WS_P) + (size_t)b * T * EVEN_N;
    const u64* MASK = (const u64*)(ws + WS_MASK);
    u16* O = (u16*)(ws + WS_O16);
    const int t0 = qb * 32, NT = ((t0 + 31) >> 6) + 1;
    LAS u64* ml = (LAS u64*)(F.lds + A_AUX);
    LAS float* wsf = (LAS float*)(F.lds + WSCR_OFF + wave * 1024);
    for (int i = F.tid; i < NT * 32; i += 512) { const int q = i & 31, tl = i >> 5; ml[tl * 32 + q] = ((const GAS u64*)MASK)[(size_t)(b * T + t0 + q) * 64 + tl]; }
    half8 qr[4];
    { const u16* qp = Pb + (size_t)(t0 + r32) * EVEN_N + C_QA + wave * 64 + hi * 8;
#pragma unroll
      for (int d0 = 0; d0 < 4; ++d0) qr[d0] = *(const GAS half8*)(qp + d0 * 16); }
    f32x16 o[2]; float m = NEG_BIG, l = 0.f;
#pragma unroll
    for (int d0 = 0; d0 < 2; ++d0)
#pragma unroll
        for (int r = 0; r < 16; ++r) o[d0][r] = 0.f;
    const u64 tiles = (NT >= 64) ? ~0ull : ((1ull << NT) - 1ull);
    attn_dma_loop<1>(F, Pb + C_KA, EVEN_N, Pb + C_VA, EVEN_N, tiles, 0, 0, ~0ull, ml, qr, o, m, l);
    float rli[16]; finalize_rows(l, 1.0f, wsf, r32, hi, rli);
    LAS u16* stg = (LAS u16*)(F.lds + A_AUX + 32768 + wave * 4096);
#pragma unroll
    for (int r = 0; r < 16; ++r)
#pragma unroll
        for (int d0 = 0; d0 < 2; ++d0) stg[crow(r, hi) * 64 + d0 * 32 + r32] = (u16)(pkh(o[d0][r] * rli[r], 0.f) & 0xffffu);
    flush_stage<64>(stg, O + (size_t)(b * T + t0) * DM + wave * 64, lane);
}

__device__ __forceinline__ float sigmoidf_(float x) { return 1.0f / (1.0f + __expf(-x)); }
__device__ __forceinline__ u64 wave_or64(u64 v) {
    unsigned lo = (unsigned)v, hh = (unsigned)(v >> 32);
#pragma unroll
    for (int o = 1; o < 64; o <<= 1) { lo |= __shfl_xor(lo, o); hh |= __shfl_xor(hh, o); }
    return ((u64)hh << 32) | lo;
}

__device__ __forceinline__ void nsa_unit(const Frame& F, int b, int g, int qb) {
    const int lane = F.lane, wave = F.wave, r32 = lane & 31, hi = lane >> 5;
    const int j = wave & 3, qs = wave >> 2, hb = g * 4 + j;
    unsigned char* ws = F.ws;
    const u16* Pb = (const u16*)(ws + WS_P) + (size_t)b * T * EVEN_N;
    const u16* KVC = (const u16*)(ws + WS_KVC);
    u16* O = (u16*)(ws + WS_O16);
    const int t0 = qb * 64, tq = t0 + 32 * qs + r32, cur = qb;
    LAS float* wsf = (LAS float*)(F.lds + WSCR_OFF + wave * 1024);
    LAS unsigned* imp = (LAS unsigned*)(F.lds + A_AUX);
    LAS u64* selm = (LAS u64*)(F.lds + A_AUX + 16896);
    for (int i = F.tid; i < 64 * 65; i += 512) imp[i] = 0u;
    const GAS u16* prow = (const GAS u16*)Pb + (size_t)tq * EVEN_N;
    half8 qr[4];
#pragma unroll
    for (int d0 = 0; d0 < 4; ++d0) qr[d0] = *(const GAS half8*)(prow + C_QB + hb * 64 + hi * 8 + d0 * 16);
    const float g0 = sigmoidf_(h2f(prow[C_GB + hb * 3 + 0])), g1 = sigmoidf_(h2f(prow[C_GB + hb * 3 + 1])), g2 = sigmoidf_(h2f(prow[C_GB + hb * 3 + 2]));
    unsigned oacc[2][8]; f32x16 o[2]; float m, l, rli[16];
#pragma unroll
    for (int d0 = 0; d0 < 2; ++d0)
#pragma unroll
        for (int r = 0; r < 8; ++r) oacc[d0][r] = 0u;
    const u16* kc = KVC + (size_t)((0 * 4 + b) * 2 + g) * 256 * 256;
    const u16* vc = KVC + (size_t)((1 * 4 + b) * 2 + g) * 256 * 256;
    const int ncmp = (tq >= 31) ? ((tq - 31) >> 4) : -1;
    const int ntc = ((t0 + 32) >> 10) + 1;
    u64 mysel = ~0ull, uni = 0ull;
    for (int br = 0; br < 3; ++br) {
        const u16* Kg; const u16* Vg; int pitch, kmax, kmin; u64 tiles, rsel; float gate;
        if (br == 0) { Kg = kc; Vg = vc; pitch = 256; kmax = ncmp; kmin = -(1 << 30); tiles = (1ull << ntc) - 1ull; rsel = ~0ull; gate = g0; }
        else if (br == 1) { Kg = Pb + C_KS + g * 64; Vg = Pb + C_VS + g * 64; pitch = EVEN_N; kmax = tq; kmin = -(1 << 30); tiles = uni; rsel = mysel; gate = g1; }
        else { Kg = Pb + (g ? C_KW1 : C_KW0); Vg = Pb + C_VW + g * 64; pitch = EVEN_N; kmax = tq; kmin = tq - 511; rsel = ~0ull; gate = g2;
               const int tlo = (cur - 8 > 0) ? cur - 8 : 0; tiles = ((cur == 63) ? ~0ull : ((1ull << (cur + 1)) - 1ull)) & ~((1ull << tlo) - 1ull); }
#pragma unroll
        for (int d0 = 0; d0 < 2; ++d0)
#pragma unroll
            for (int r = 0; r < 16; ++r) o[d0][r] = 0.f;
        m = NEG_BIG; l = 0.f;
        attn_dma_loop<0>(F, Kg, pitch, Vg, pitch, tiles, kmax, kmin, rsel, (const LAS u64*)nullptr, qr, o, m, l);
        const float lc = swap_sum(l), invc = 1.0f / fmaxf(lc, 1e-30f), mc = m;
        finalize_rows(l, gate, wsf, r32, hi, rli);
#pragma unroll
        for (int d0 = 0; d0 < 2; ++d0)
#pragma unroll
            for (int r = 0; r < 16; r += 2) oacc[d0][r >> 1] = pkh(h2f(oacc[d0][r >> 1] & 0xffffu) + o[d0][r] * rli[r], h2f(oacc[d0][r >> 1] >> 16) + o[d0][r + 1] * rli[r + 1]);
        if (br == 0) {
            u32x4 kr[1];
            stage_load_k<64>(kr, kc, 256, F.tid); stage_write_k<64>(F.lds + A_KB, kr, F.tid);
            __syncthreads();
            int cb = 0; const int qi = 32 * qs + r32;
            f32x16 negmc;
#pragma unroll
            for (int r = 0; r < 16; ++r) negmc[r] = -mc;
            for (int tl = 0; tl < ntc; ++tl) {
                const bool more = tl + 1 < ntc;
                if (more) stage_load_k<64>(kr, kc + (size_t)(tl + 1) * 64 * 256, 256, F.tid);
                f32x16 p0, p1;
                qk_tile<64>(p0, p1, F.lds + A_KB + cb * 16384, 0, r32, hi, qr, negmc);
                const int dd = ncmp - (64 * tl + 4 * hi);
#pragma unroll
                for (int r = 0; r < 16; ++r) {
                    p0[r] = (dd >= crow(r, 0)) ? __builtin_amdgcn_exp2f(p0[r]) * invc : 0.f;
                    p1[r] = (dd >= crow(r, 0) + 32) ? __builtin_amdgcn_exp2f(p1[r]) * invc : 0.f;
                }
#pragma unroll
                for (int i = 0; i < 4; ++i) {
                    { const float g4 = (p0[4 * i] + p0[4 * i + 1]) + (p0[4 * i + 2] + p0[4 * i + 3]); const int mi = tl * 16 + 2 * i + hi;
                      __hip_atomic_fetch_add(imp + qi * 65 + mi, (unsigned)(g4 * 67108864.0f + 0.5f), __ATOMIC_RELAXED, __HIP_MEMORY_SCOPE_WORKGROUP);
                      if (mi + 1 < 64) __hip_atomic_fetch_add(imp + qi * 65 + mi + 1, (unsigned)(p0[4 * i + 3] * 67108864.0f + 0.5f), __ATOMIC_RELAXED, __HIP_MEMORY_SCOPE_WORKGROUP); }
                    { const float g4 = (p1[4 * i] + p1[4 * i + 1]) + (p1[4 * i + 2] + p1[4 * i + 3]); const int mi = tl * 16 + 8 + 2 * i + hi;
                      __hip_atomic_fetch_add(imp + qi * 65 + mi, (unsigned)(g4 * 67108864.0f + 0.5f), __ATOMIC_RELAXED, __HIP_MEMORY_SCOPE_WORKGROUP);
                      if (mi + 1 < 64) __hip_atomic_fetch_add(imp + qi * 65 + mi + 1, (unsigned)(p1[4 * i + 3] * 67108864.0f + 0.5f), __ATOMIC_RELAXED, __HIP_MEMORY_SCOPE_WORKGROUP); }
                }
                if (more) stage_write_k<64>(F.lds + A_KB + (cb ^ 1) * 16384, kr, F.tid);
                __syncthreads(); cb ^= 1;
            }
            for (int qq = 0; qq < 8; ++qq) {
                const int q = wave * 8 + qq;
                unsigned key = imp[q * 65 + lane];
                if (lane == 0 || lane == cur || lane == cur - 1) key = 0x7fffffffu;
                const bool adm = lane <= cur;
                u64 mk;
                if (cur < 16) mk = __ballot(adm);
                else {
                    unsigned thr = 0u;
                    for (int bit = 30; bit >= 0; --bit) { const unsigned cand = thr | (1u << bit); if (__popcll(__ballot(adm && key >= cand)) >= 16) thr = cand; }
                    const u64 gt = __ballot(adm && key > thr);
                    u64 eq = __ballot(adm && key == thr);
                    int need = 16 - __popcll(gt), c = __popcll(eq);
                    while (c > need) { eq &= ~(1ull << (63 - __clzll(eq))); --c; }
                    mk = gt | eq;
                }
                if (lane == 0) selm[q] = mk;
            }
            __syncthreads();
            mysel = selm[32 * qs + r32];
            uni = wave_or64(selm[lane]);
        }
    }
    GAS u16* Ob = (GAS u16*)O + (size_t)(b * T + t0 + 32 * qs) * DM + 512 + hb * 64 + r32;
#pragma unroll
    for (int r = 0; r < 16; ++r)
#pragma unroll
        for (int d0 = 0; d0 < 2; ++d0) Ob[(size_t)crow(r, hi) * DM + d0 * 32] = (u16)((oacc[d0][r >> 1] >> (16 * (r & 1))) & 0xffffu);
    __syncthreads();
}

__device__ __forceinline__ void diff_unit(const Frame& F, int b, int h, int qb, float lam_val, float oml, const float* sg) {
    int lane = F.lane; asm volatile("" : "+v"(lane));
    const int wave = F.wave, r32 = lane & 31, hi = lane >> 5;
    const int c = wave >> 2, qs = wave & 3;
    unsigned char* ws = F.ws;
    const u16* Pb = (const u16*)(ws + WS_P) + (size_t)b * T * ODD_N;
    u16* O = (u16*)(ws + WS_O16);
    const int t0 = qb * 128, tq = t0 + 32 * qs + r32;
    LAS float* wsf = (LAS float*)(F.lds + WSCR_OFF + wave * 1024);
    half8 qr[4];
#pragma unroll
    for (int d0 = 0; d0 < 4; ++d0) qr[d0] = *(const GAS half8*)(Pb + (size_t)tq * ODD_N + (2 * h + c) * 64 + hi * 8 + d0 * 16);
    f32x16 o[4]; float m = NEG_BIG, l = 0.f, rli[16];
#pragma unroll
    for (int d0 = 0; d0 < 4; ++d0)
#pragma unroll
        for (int r = 0; r < 16; ++r) o[d0][r] = 0.f;
    const int NT = 2 * (qb + 1);
    const u64 tiles = (NT >= 64) ? ~0ull : ((1ull << NT) - 1ull);
    diff_loop_hs(F, Pb + 1024 + 2 * h * 64, Pb + 2048 + h * 128, NT, tq, 8 * c, qr, o, l); (void)m;
    finalize_rows(l, 1.0f, wsf, r32, hi, rli);
    LAS float* stg = (LAS float*)(F.lds) + (size_t)qs * 32 * 128;
    if (c == 1) {
#pragma unroll
        for (int r = 0; r < 16; ++r)
#pragma unroll
            for (int d0 = 0; d0 < 4; ++d0) stg[crow(r, hi) * 128 + d0 * 32 + r32] = o[d0][r] * rli[r];
    }
    __syncthreads();
    if (c == 0) {
        LAS float* ssb = (LAS float*)(F.lds + 65536 + qs * 16384);
        LAS u16* ost = (LAS u16*)(F.lds + 65536 + qs * 16384 + 8192);
#pragma unroll
        for (int r = 0; r < 16; ++r) {
            float ss = 0.f;
#pragma unroll
            for (int d0 = 0; d0 < 4; ++d0) { o[d0][r] = o[d0][r] * rli[r] - lam_val * stg[crow(r, hi) * 128 + d0 * 32 + r32]; ss += o[d0][r] * o[d0][r]; }
            ssb[crow(r, hi) * 36 + r32] = ss;
        }
        asm volatile("s_waitcnt lgkmcnt(0)" ::: "memory");
        { const int row = lane >> 1, half = lane & 1;
          const LAS f32x4* sp_ = (const LAS f32x4*)(ssb + row * 36 + half * 16);
          const f32x4 a0 = sp_[0], a1 = sp_[1], a2 = sp_[2], a3 = sp_[3];
          float tot = ((a0.x + a0.y) + (a0.z + a0.w)) + ((a1.x + a1.y) + (a1.z + a1.w)) + ((a2.x + a2.y) + (a2.z + a2.w)) + ((a3.x + a3.y) + (a3.z + a3.w));
          tot += __shfl_xor(tot, 1);
          const float rs = 1.0f / sqrtf(tot * (1.0f / 128.0f) + 1e-6f);
          if (half == 0) wsf[64 + row] = rs; }
        asm volatile("s_waitcnt lgkmcnt(0)" ::: "memory");
        float sgv[4];
#pragma unroll
        for (int d0 = 0; d0 < 4; ++d0) sgv[d0] = ((const GAS float*)sg)[d0 * 32 + r32] * oml;
#pragma unroll
        for (int r = 0; r < 16; ++r) { const float rs = wsf[64 + crow(r, hi)];
#pragma unroll
            for (int d0 = 0; d0 < 4; ++d0) ost[crow(r, hi) * 128 + d0 * 32 + r32] = (u16)(pkh(o[d0][r] * rs * sgv[d0], 0.f) & 0xffffu); }
        flush_stage<128>(ost, O + (size_t)(b * T + t0 + 32 * qs) * DM + h * 128, lane);
    }
    __syncthreads();
}

__device__ __forceinline__ void even_attn_phase(const Frame& F, int layer) {
    unsigned char* ws = F.ws;
    const u16* P = (const u16*)(ws + WS_P); u16* O = (u16*)(ws + WS_O16);
    const u64* MASK = (const u64*)(ws + WS_MASK);
    const u16* KVC = (const u16*)(ws + WS_KVC);
    const int gw = F.bid * 8 + F.wave, NGW = F.G * 8, lane = F.lane;
    LAS float* pbuf = (LAS float*)(F.lds + F.wave * 16384);
    if (F.G == 256) {
        const int xcd = F.bid & 7, jx = F.bid >> 3, b = xcd >> 1, i = (xcd & 1) * 32 + jx;
        for (int k = 0; k < 2; ++k) dsa_unit(F, b, k ? 127 - i : i);
#if PROBE_VAR >= 0
        __syncthreads();
        if (layer == 0) { for (int k = 0; k < 2; ++k) dsa_probe_unit<PROBE_VAR>(F, b, k ? 127 - i : i); }
#endif
    }
    __syncthreads();
    if (F.G == 256) {
        const int b = (F.bid & 7) >> 1, g = F.bid & 1, i = F.bid >> 3;
#ifndef NO_NSA
        for (int k = 0; k < 2; ++k) nsa_unit(F, b, g, k ? 63 - i : i);
#endif
    }
}

__device__ __forceinline__ void odd_attn_phase(const Frame& F, int layer) {
    const ArgsP ap = F.a; unsigned char* ws = F.ws; const int oi = layer >> 1;
    const u16* P = (const u16*)(ws + WS_P); u16* O = (u16*)(ws + WS_O16);
    const int gw = F.bid * 8 + F.wave, NGW = F.G * 8, lane = F.lane;
    LAS float* pbuf = (LAS float*)(F.lds + F.wave * 16384);
    const float* lam = G(ap->odd_lambda) + (size_t)oi * 4 * 64;
    const float l01 = wave_sum(lam[lane] * lam[64 + lane]), l23 = wave_sum(lam[128 + lane] * lam[192 + lane]);
    const float lambda_init = 0.8f - 0.6f * expf(-0.3f * (float)layer);
    const float lam_val = expf(l01) - expf(l23) + lambda_init;
    const float* sg = G(ap->odd_subln) + (size_t)oi * 128;
    if (F.G == 256) {
        const int bh = (F.bid & 7) * 4 + ((F.bid >> 3) >> 3), s8 = (F.bid >> 3) & 7;
#ifndef NO_DIFF
        for (int k = 0; k < 4; ++k) diff_unit(F, bh >> 3, bh & 7, (k == 0) ? s8 : (k == 1) ? 15 - s8 : (k == 2) ? 16 + s8 : 31 - s8, lam_val, 1.0f - lambda_init, sg);
#endif
    }
}

__device__ __forceinline__ void final_phase(const Frame& F) {
    const ArgsP ap = F.a; const float* psum = (const float*)(F.ws + WS_PSUM);
    const int gw = F.bid * 8 + F.wave, NGW = F.G * 8;
    for (int row = gw; row < M; row += NGW) {
        const float rs = pg8::rowscale(psum, row);
        f32x4* orow = (f32x4*)(G(ap->out) + (size_t)row * DM) + F.lane;
        const f32x4* gg = (const f32x4*)G(ap->final_g) + F.lane;
#pragma unroll
        for (int j = 0; j < 4; ++j) { f32x4 v = orow[64 * j]; const f32x4 g = gg[64 * j]; v = v * rs * g; orow[64 * j] = v; }
    }
}

__global__ void __launch_bounds__(512, 2) trunk_fwd(Args args) {
    extern __shared__ __attribute__((aligned(16))) unsigned char lds_raw[];
    Frame F;
    F.lds = (LAS unsigned char*)lds_raw; F.tid = threadIdx.x; F.lane = F.tid & 63; F.wave = __builtin_amdgcn_readfirstlane(F.tid >> 6);
    F.G = gridDim.x; F.bid = blockIdx.x; F.a = kargs(); F.ws = G(F.a->ws);
    unsigned char* ws = F.ws;
    const int ph_lo = F.a->ph_lo, ph_hi = F.a->ph_hi;
    for (int u = F.tid; u < (LDS_BYTES - LDSCTL_OFF) / 4; u += 512) ((LAS unsigned*)(F.lds + LDSCTL_OFF))[u] = 0u;
    __syncthreads();
    const bool multi = (ph_hi - ph_lo) > 1;
    const int wave_s = F.wave;
    XcdBarrier bar; bar.bar = (unsigned*)(ws + WS_CTL) + CW_BAR; bar.x = 0; bar.st = nullptr;
    if (multi) bar = xcd_barrier_post((unsigned*)(ws + WS_CTL) + CW_BAR, (volatile LAS unsigned*)(F.lds + MISC_OFF));

    const float* psum = nullptr;
#ifndef DUP_KIND
#define DUP_KIND -1
#endif
#ifndef DUP_PAR
#define DUP_PAR -1
#endif
    int dup_done = 0;
    for (int ph = ph_lo; ph < ph_hi; ++ph) {
        int layer, kind; phase_decode(ph, layer, kind);
        if (DUP_KIND >= 0 && kind == DUP_KIND && (DUP_PAR < 0 || (layer & 1) == DUP_PAR) && !dup_done) { dup_done = 1; --ph; }
        else dup_done = 0;
        F.a = kargs();
        { unsigned char* w_ = F.a->ws; int g_ = gridDim.x, b_ = blockIdx.x; asm volatile("" : "+s"(w_), "+s"(g_), "+s"(b_)); w_ = G(w_); ws = w_; F.ws = w_; F.G = g_; F.bid = b_; psum = (const float*)(w_ + WS_PSUM); }
        { int w_ = wave_s, z_ = 0; asm volatile("" : "+s"(w_), "+v"(z_)); int tid_ = w_ * 64 + (int)__builtin_amdgcn_mbcnt_hi(~0u, __builtin_amdgcn_mbcnt_lo(~0u, (unsigned)z_)); asm volatile("" : "+v"(tid_));     F.tid = tid_; F.lane = tid_ & 63; F.wave = __builtin_amdgcn_readfirstlane(tid_ >> 6); }
        const bool odd = (layer & 1) != 0;
#ifndef NO_PREP
        if (kind == K_PREP) prep_phase(F, layer); else
#endif
        if (0) {}
#ifndef NO_INPROJ
        else if (kind == K_INPROJ) {
            const int N = odd ? ODD_N : EVEN_N, NG = odd ? ODD_N : 2048;
            pg8::Gemm g{(const u16*)(ws + WS_X16), (const u16*)(ws + WS_WIN), M, NG, DM};
            pg8::StaticOrder S; S.init(M, NG, F.G, F.bid);
            const u64 rope_even = 0xFFull | (1ull << 8) | (0xFull << 10) | (1ull << 14) | (0xFFull << 15) | (3ull << 23) | (3ull << 27) | (1ull << 32) | (1ull << 35);
            const u64 scale_even = 0xFFull | (0xFFull << 15);
            const u64 rope_odd = 0xFFFFFFFFull, scale_odd = 0xFFFFull;
            pg8::EpiProj E{(u16*)(ws + WS_P), N, psum, (const float*)(ws + WS_COS), (const float*)(ws + WS_SIN), odd ? rope_odd : rope_even, odd ? scale_odd : scale_even, odd ? (u16*)nullptr : (u16*)(ws + WS_KIF)};
            pg8::gemm_phase<pg8::EpiProj, pg8::StaticOrder, true, true>(F.lds, F.tid, g, S, E);
        }
#endif
#ifndef NO_PRE
        else if (kind == K_PRE) pre_phase(F, layer);
#endif
#ifndef NO_CMP
        else if (kind == K_CMP1) {
            pg8::Gemm g{(const u16*)(ws + WS_AC), (const u16*)(ws + WS_WC1), 4096, 512, 2048};
            int one_ = 1; asm volatile("" : "+s"(one_)); pg8::DiagOrder S{F.bid, one_}; pg8::EpiCmp<1> E{(u16*)(ws + WS_HC)};
            pg8::gemm_phase<pg8::EpiCmp<1>, pg8::DiagOrder, true, true>(F.lds, F.tid, g, S, E);
            pg8::Gemm g2{(const u16*)(ws + WS_X16), (const u16*)(ws + WS_WIN), M, EVEN_N, DM};
            pg8::TailOrder S2{F.bid, one_};
            const u64 rope_even = 0xFFull | (1ull << 8) | (0xFull << 10) | (1ull << 14) | (0xFFull << 15) | (3ull << 23) | (3ull << 27) | (1ull << 32) | (1ull << 35);
            pg8::EpiProj E2{(u16*)(ws + WS_P), EVEN_N, psum, (const float*)(ws + WS_COS), (const float*)(ws + WS_SIN), rope_even, 0xFFull | (0xFFull << 15), (u16*)nullptr};
            pg8::gemm_phase<pg8::EpiProj, pg8::TailOrder, true, true>(F.lds, F.tid, g2, S2, E2);
            if (F.G > 80 && F.bid >= 80) { Frame F2 = F; F2.bid = F.bid - 80; F2.G = F.G - 80;
                conv_weight<0>(F2, G(F.a->mlp_down) + (size_t)layer * DFF * DM, DFF, DM, (u16*)(ws + WS_WDN), nullptr); }
        }
        else if (kind == K_CMP2) {
            int k256_ = 256; asm volatile("" : "+s"(k256_));
            pg8::Gemm g{(const u16*)(ws + WS_HC), (const u16*)(ws + WS_WC2), 4096, 512, k256_};
            int one_ = 1; asm volatile("" : "+s"(one_)); pg8::DiagOrder S{F.bid, one_}; pg8::EpiCmp<0> E{(u16*)(ws + WS_KVC)};
            pg8::gemm_phase<pg8::EpiCmp<0>, pg8::DiagOrder, true, true>(F.lds, F.tid, g, S, E);
        }
#endif
#ifndef NO_ATTN
        else if (kind == K_ATTN) { if (odd) odd_attn_phase(F, layer); else even_attn_phase(F, layer); }
#endif
#ifndef NO_OUT
        else if (kind == K_OUTPROJ) {
            pg8::Gemm g{(const u16*)(ws + WS_O16), (const u16*)(ws + WS_WOUT), M, DM, DM};
            pg8::StaticOrder S; S.init(M, DM, F.G, F.bid);
            pg8::EpiResid E{layer == 0 ? G(F.a->x) : (const float*)G(F.a->out), G(F.a->out), (u16*)(ws + WS_X16), (float*)(ws + WS_PSUM)};
            pg8::gemm_phase<pg8::EpiResid, pg8::StaticOrder, true, true>(F.lds, F.tid, g, S, E);
        }
#endif
#ifndef NO_UP
        else if (kind == K_UP) {
            pg8::Gemm g{(const u16*)(ws + WS_X16), (const u16*)(ws + WS_WUP), M, DFF, DM};
            pg8::StaticOrder S; S.init(M, DFF, F.G, F.bid);
            pg8::EpiUp E{(u16*)(ws + WS_U), DFF, psum};
            pg8::gemm_phase<pg8::EpiUp, pg8::StaticOrder, true, true>(F.lds, F.tid, g, S, E);
        }
#endif
#ifndef NO_DOWN
        else if (kind == K_DOWN) {
            pg8::Gemm g{(const u16*)(ws + WS_U), (const u16*)(ws + WS_WDN), M, DM, DFF};
            pg8::StaticOrder S; S.init(M, DM, F.G, F.bid);
            pg8::EpiResid E{(const float*)G(F.a->out), G(F.a->out), (u16*)(ws + WS_X16), (float*)(ws + WS_PSUM)};
            pg8::gemm_phase<pg8::EpiResid, pg8::StaticOrder, true, true>(F.lds, F.tid, g, S, E);
        }
#endif
        else final_phase(F);
        if (ph + 1 < ph_hi || dup_done) xcd_barrier(bar);
    }
}

extern "C" void kernel_launch(void* const* d_in, const int* in_sizes, int n_in, void* d_out, int out_size, void* d_ws, size_t ws_size, hipStream_t stream) {
    static int grid = 0;
    if (grid == 0) {
        if (n_in != 15 || out_size != M * DM || ws_size < WS_END) { fprintf(stderr, "kernel_launch: unexpected shapes (n_in %d out %d ws %zu)\n", n_in, out_size, ws_size); grid = -1; return; }
        int dev = 0, cus = 0;
        if (hipGetDevice(&dev) != hipSuccess || hipDeviceGetAttribute(&cus, hipDeviceAttributeMultiprocessorCount, dev) != hipSuccess) { grid = -1; return; }
        if (hipFuncSetAttribute((const void*)trunk_fwd, hipFuncAttributeMaxDynamicSharedMemorySize, LDS_BYTES) != hipSuccess) { fprintf(stderr, "kernel_launch: hipFuncSetAttribute failed\n"); grid = -1; return; }
        int per_cu = 0;
        if (hipOccupancyMaxActiveBlocksPerMultiprocessor(&per_cu, (const void*)trunk_fwd, 512, LDS_BYTES) != hipSuccess || per_cu < 1) { fprintf(stderr, "kernel_launch: occupancy query says %d\n", per_cu); }
        (void)hipGetLastError();
        grid = cus;
    }
    if (grid < 0) return;
    (void)hipMemsetAsync((char*)d_ws + WS_CTL, 0, CTL_ZERO_BYTES, stream);
    Args a{};
    a.x = (const float*)d_in[0]; a.mix_g = (const float*)d_in[1]; a.mlp_g = (const float*)d_in[2]; a.even_w_in = (const float*)d_in[3]; a.even_pe = (const float*)d_in[4];
    a.even_w1 = (const float*)d_in[5]; a.even_w2 = (const float*)d_in[6]; a.even_w_out = (const float*)d_in[7]; a.odd_w_in = (const float*)d_in[8]; a.odd_lambda = (const float*)d_in[9];
    a.odd_subln = (const float*)d_in[10]; a.odd_w_out = (const float*)d_in[11]; a.mlp_up = (const float*)d_in[12]; a.mlp_down = (const float*)d_in[13]; a.final_g = (const float*)d_in[14];
    a.out = (float*)d_out; a.ws = (unsigned char*)d_ws;
#if MK_ONE_LAUNCH
    a.ph_lo = 0; a.ph_hi = NPHASE;
    hipLaunchKernelGGL(trunk_fwd, dim3(grid), dim3(512), LDS_BYTES, stream, a);
#else
    for (int ph = 0; ph < NPHASE; ++ph) { a.ph_lo = ph; a.ph_hi = ph + 1; hipLaunchKernelGGL(trunk_fwd, dim3(grid), dim3(512), LDS_BYTES, stream, a); }
#endif
}
```

```cpp
#include <hip/hip_runtime.h>
#include <cstdio>
#include <cstdint>

#ifndef MK_ONE_LAUNCH
#define MK_ONE_LAUNCH 1
#endif

#define LAS __attribute__((address_space(3)))
#define GAS __attribute__((address_space(1)))
typedef unsigned short u16;
typedef _Float16 half8 __attribute__((ext_vector_type(8)));
typedef short s16x8 __attribute__((ext_vector_type(8)));
typedef float f32x4 __attribute__((ext_vector_type(4)));
typedef unsigned u32x4 __attribute__((ext_vector_type(4)));
typedef unsigned u32x2 __attribute__((ext_vector_type(2)));
typedef unsigned long long u64;

constexpr int NB = 4, T = 4096, M = NB * T, DM = 1024, DFF = 4096;
constexpr int EVEN_N = 2304, ODD_N = 3072;
constexpr int C_QA = 0, C_KA = 512, C_VA = 576, C_QI = 640, C_KI = 896, C_QB = 960, C_KVB = 1472, C_WI = 1984, C_GB = 1988;
constexpr int C_KC = C_KVB, C_VC = C_KVB + 128, C_KS = C_KVB + 256, C_VS = C_KVB + 384;
constexpr int C_KW0 = 2240, C_KW1 = 2048, C_VW = 2112;
constexpr float QSCALE = 0.125f * 1.4426950408889634f;

__device__ const float ROPE_INV[32] = {
    1.000000000e+00f, 7.498942018e-01f, 5.623413324e-01f, 4.216965139e-01f, 3.162277639e-01f, 2.371373922e-01f, 1.778279394e-01f, 1.333521456e-01f,
    1.000000015e-01f, 7.498941571e-02f, 5.623412877e-02f, 4.216964915e-02f, 3.162277862e-02f, 2.371373586e-02f, 1.778279431e-02f, 1.333521493e-02f,
    9.999999776e-03f, 7.498942316e-03f, 5.623413250e-03f, 4.216964822e-03f, 3.162277862e-03f, 2.371373819e-03f, 1.778279431e-03f, 1.333521446e-03f,
    1.000000047e-03f, 7.498941850e-04f, 5.623413017e-04f, 4.216965463e-04f, 3.162277862e-04f, 2.371373848e-04f, 1.778279402e-04f, 1.333521504e-04f};

template <class Tp> __device__ __forceinline__ Tp* G(Tp* p) { return (Tp*)(GAS Tp*)p; }
__device__ __forceinline__ unsigned pkh(float a, float b) { auto v = __builtin_amdgcn_cvt_pkrtz(a, b); return __builtin_bit_cast(unsigned, v); }
__device__ __forceinline__ float h2f(unsigned x) { return (float)__builtin_bit_cast(_Float16, (u16)x); }
__device__ __forceinline__ float wave_sum(float v) {
#pragma unroll
    for (int o = 1; o < 64; o <<= 1) v += __shfl_xor(v, o);
    return v;
}
__device__ __forceinline__ float wave_max(float v) {
#pragma unroll
    for (int o = 1; o < 64; o <<= 1) v = fmaxf(v, __shfl_xor(v, o));
    return v;
}
__device__ __forceinline__ void unpack8(const u32x4 w, float* f) {
    f[0] = h2f(w.x & 0xffffu); f[1] = h2f(w.x >> 16); f[2] = h2f(w.y & 0xffffu); f[3] = h2f(w.y >> 16);
    f[4] = h2f(w.z & 0xffffu); f[5] = h2f(w.z >> 16); f[6] = h2f(w.w & 0xffffu); f[7] = h2f(w.w >> 16);
}

namespace pg8 {
constexpr int BM = 256, BK = 64, HALF = 128, HTB = HALF * BK * 2, STAGE_BYTES = 8 * HTB, NXCD = 8, WGM = 8;
__host__ __device__ __forceinline__ int lds_byte(int r, int c) { const int st = (r >> 4) * 2 + (c >> 5), rr = r & 15, cc = c & 31, ob = rr * 64 + cc * 2; return st * 1024 + (ob ^ (((ob >> 9) & 1) << 5)); }
__host__ __device__ __forceinline__ void stage_rc(int b, int& R, int& C) { const int st = b / 1024, sb = b % 1024, swz = sb ^ (((sb >> 9) & 1) << 5); R = (st >> 1) * 16 + swz / 64; C = (st & 1) * 32 + (swz % 64) / 2; }
__host__ __device__ __forceinline__ int perm32(int rho) { const int n = rho >> 4, i = rho & 15; return 8 * (i >> 2) + 4 * n + (i & 3); }

struct Unit { int pm, pn; };
struct Gemm { const u16* A; const u16* Bt; int M, N, K; };

struct StaticOrder {
    int nM, nN, nwg, G, c;
    __host__ __device__ void init(int M_, int N_, int G_, int c_) { nM = M_ / BM; nN = N_ / BM; nwg = nM * nN; G = G_; c = c_; }
    __host__ __device__ bool next(int i, Unit& u) const {
        const long L = (long)i * G + c; if (L >= nwg) return false;
        int wgid = (int)L; { const int q = nwg / NXCD, r = nwg % NXCD, xcd = wgid % NXCD, off = wgid / NXCD; wgid = (xcd < r ? xcd * (q + 1) : r * (q + 1) + (xcd - r) * q) + off; }
        const int nig = WGM * nN, gid = wgid / nig, fm = gid * WGM, gsz = (nM - fm) < WGM ? (nM - fm) : WGM;
        u.pm = fm + ((wgid % nig) % gsz); u.pn = (wgid % nig) / gsz; return true;
    }
};
struct DiagOrder {
    int c, n;
    __host__ __device__ bool next(int i, Unit& u) const { if (i >= n || c >= 16) return false; u.pm = c; u.pn = c >> 3; return true; }
};

struct TailOrder {
    int c, n;
    __host__ __device__ bool next(int i, Unit& u) const { if (i >= n || c < 16 || c >= 80) return false; u.pm = c - 16; u.pn = 8; return true; }
};

__device__ __forceinline__ float rowscale(const float* psum, int row) {
    const GAS f32x4* p = (const GAS f32x4*)(psum + (size_t)row * 16);
    const f32x4 a = p[0], b = p[1], c = p[2], d = p[3];
    const float s = (((a.x + a.y) + (a.z + a.w)) + ((b.x + b.y) + (b.z + b.w))) + (((c.x + c.y) + (c.z + c.w)) + ((d.x + d.y) + (d.z + d.w)));
    return 1.0f / sqrtf(s * (1.0f / 1024.0f) + 1e-6f);
}

__device__ __forceinline__ void rowscales8(const float* psum, int rowbase  , int fq, float (&rs)[2][4]) {
    f32x4 ps[2][4];
#pragma unroll
    for (int ai = 0; ai < 2; ++ai)
#pragma unroll
        for (int m = 0; m < 4; ++m) ps[ai][m] = *(const GAS f32x4*)(psum + (size_t)(rowbase + ai * HALF + m * 16) * 16 + 4 * fq);
#pragma unroll
    for (int ai = 0; ai < 2; ++ai)
#pragma unroll
        for (int m = 0; m < 4; ++m) { float t = (ps[ai][m].x + ps[ai][m].y) + (ps[ai][m].z + ps[ai][m].w); t += __shfl_xor(t, 16); t += __shfl_xor(t, 32);
            rs[ai][m] = 1.0f / sqrtf(t * (1.0f / 1024.0f) + 1e-6f); }
}
struct EpiProj {
    static constexpr bool PERM = true, AFTER_DRAIN = false;
    u16* P; int ldp; const float* psum; const float* cosT; const float* sinT; u64 rope_mask, scale_mask; u16* kif;
    __device__ __forceinline__ void operator()(const f32x4 (&acc)[2][2][4][2], const Unit& u, int wr, int wc, int fr, int fq) const {
        const int d0 = 16 * (wc & 1) + 4 * fq, rowbase = u.pm * BM + wr * 64 + fr;
        float rs[2][4]; rowscales8(psum, rowbase, fq, rs);
        f32x4 cn, sn;
        { const int t = rowbase & (T - 1); cn = *(const GAS f32x4*)(cosT + t * 32 + d0); sn = *(const GAS f32x4*)(sinT + t * 32 + d0); }
#pragma unroll
        for (int ai = 0; ai < 2; ++ai)
#pragma unroll
            for (int m = 0; m < 4; ++m) {
                const int row = rowbase + ai * HALF + m * 16;
                const f32x4 c4 = cn, s4 = sn;
                if (ai * 4 + m < 7) { const int rn = rowbase + ((ai * 4 + m + 1) >> 2) * HALF + ((ai * 4 + m + 1) & 3) * 16, t = rn & (T - 1);
                    cn = *(const GAS f32x4*)(cosT + t * 32 + d0); sn = *(const GAS f32x4*)(sinT + t * 32 + d0); }
#pragma unroll
                for (int bj = 0; bj < 2; ++bj) {
                    const int head = u.pn * 4 + bj * 2 + (wc >> 1);
                    f32x4 v0 = acc[ai][bj][m][0] * rs[ai][m], v1 = acc[ai][bj][m][1] * rs[ai][m], o0 = v0, o1 = v1;
                    if ((rope_mask >> head) & 1ull) { o0 = v0 * c4 - v1 * s4; o1 = v1 * c4 + v0 * s4; }
                    if ((scale_mask >> head) & 1ull) { o0 = o0 * QSCALE; o1 = o1 * QSCALE; }
                    u16* dst = P + (size_t)row * ldp + head * 64 + d0;
                    u32x2 w0, w1; w0.x = pkh(o0[0], o0[1]); w0.y = pkh(o0[2], o0[3]); w1.x = pkh(o1[0], o1[1]); w1.y = pkh(o1[2], o1[3]);
                    *(GAS u32x2*)dst = w0; *(GAS u32x2*)(dst + 32) = w1;
                    if (kif != nullptr && head == 14) {
                        u16* kf = kif + ((size_t)(row >> 5) * 8 * 32 + (row & 31)) * 8;
                        const int dA = d0, dB = d0 + 32;
                        *(GAS u32x2*)(kf + (size_t)(((dA >> 4) * 2 + ((dA >> 3) & 1)) * 32) * 8 + (dA & 7)) = w0;
                        *(GAS u32x2*)(kf + (size_t)(((dB >> 4) * 2 + ((dB >> 3) & 1)) * 32) * 8 + (dB & 7)) = w1;
                    }
                }
            }
    }
};
struct EpiResid {
    static constexpr bool PERM = true, AFTER_DRAIN = false;
    const float* hin; float* h; u16* x16; float* psum;
    __device__ __forceinline__ void operator()(const f32x4 (&acc)[2][2][4][2], const Unit& u, int wr, int wc, int fr, int fq) const {
        const int rowbase = u.pm * BM + wr * 64 + fr, colbase = u.pn * BM + wc * 32 + 8 * fq;
        f32x4 nx[2][2];
#pragma unroll
        for (int bj = 0; bj < 2; ++bj) { const float* p = hin + (size_t)rowbase * DM + colbase + bj * HALF; nx[bj][0] = *(const GAS f32x4*)p; nx[bj][1] = *(const GAS f32x4*)(p + 4); }
#pragma unroll
        for (int ai = 0; ai < 2; ++ai)
#pragma unroll
            for (int m = 0; m < 4; ++m) {
                const int row = rowbase + ai * HALF + m * 16; float ss = 0.f;
                f32x4 cu[2][2];
#pragma unroll
                for (int bj = 0; bj < 2; ++bj) { cu[bj][0] = nx[bj][0]; cu[bj][1] = nx[bj][1]; }
                if (ai * 4 + m < 7) { const int rn = rowbase + ((ai * 4 + m + 1) >> 2) * HALF + ((ai * 4 + m + 1) & 3) * 16;
#pragma unroll
                    for (int bj = 0; bj < 2; ++bj) { const float* p = hin + (size_t)rn * DM + colbase + bj * HALF; nx[bj][0] = *(const GAS f32x4*)p; nx[bj][1] = *(const GAS f32x4*)(p + 4); } }
#pragma unroll
                for (int bj = 0; bj < 2; ++bj) {
                    const int col = colbase + bj * HALF;
                    float* hp = h + (size_t)row * DM + col;
                    const f32x4 a = cu[bj][0] + acc[ai][bj][m][0], b = cu[bj][1] + acc[ai][bj][m][1];
                    *(GAS f32x4*)hp = a; *(GAS f32x4*)(hp + 4) = b;
                    ss += (a.x * a.x + a.y * a.y) + (a.z * a.z + a.w * a.w) + (b.x * b.x + b.y * b.y) + (b.z * b.z + b.w * b.w);
                    u32x4 w; w.x = pkh(a.x, a.y); w.y = pkh(a.z, a.w); w.z = pkh(b.x, b.y); w.w = pkh(b.z, b.w);
                    *(GAS u32x4*)(x16 + (size_t)row * DM + col) = w;
                }
                ss += __shfl_xor(ss, 16); ss += __shfl_xor(ss, 32);
                if (fq == 0) ((GAS float*)psum)[(size_t)row * 16 + u.pn * 4 + wc] = ss;
            }
    }
};
struct EpiUp {
    static constexpr bool PERM = true, AFTER_DRAIN = false;
    u16* U; int ldc; const float* psum;
    __device__ __forceinline__ void operator()(const f32x4 (&acc)[2][2][4][2], const Unit& u, int wr, int wc, int fr, int fq) const {
        const int rowbase = u.pm * BM + wr * 64 + fr;
        float rs[2][4]; rowscales8(psum, rowbase, fq, rs);
#pragma unroll
        for (int ai = 0; ai < 2; ++ai)
#pragma unroll
            for (int m = 0; m < 4; ++m) {
                const int row = rowbase + ai * HALF + m * 16;
#pragma unroll
                for (int bj = 0; bj < 2; ++bj) {
                    const int col = u.pn * BM + bj * HALF + wc * 32 + 8 * fq;
                    f32x4 a = acc[ai][bj][m][0] * rs[ai][m], b = acc[ai][bj][m][1] * rs[ai][m];
#pragma unroll
                    for (int i = 0; i < 4; ++i) { a[i] = fmaxf(a[i], 0.f); a[i] *= a[i]; b[i] = fmaxf(b[i], 0.f); b[i] *= b[i]; }
                    u32x4 w; w.x = pkh(a.x, a.y); w.y = pkh(a.z, a.w); w.z = pkh(b.x, b.y); w.w = pkh(b.z, b.w);
                    *(GAS u32x4*)(U + (size_t)row * ldc + col) = w;
                }
            }
    }
};
__device__ __forceinline__ float gelu_tanh(float x) {
    const float u = x * (1.5957691216057308f + 0.07135481627f * x * x);
    return x * __builtin_amdgcn_rcpf(1.0f + __builtin_amdgcn_exp2f(-1.4426950408889634f * u));
}
template <int ACT> struct EpiCmp {
    static constexpr bool PERM = true, AFTER_DRAIN = false;
    u16* O;
    __device__ __forceinline__ void operator()(const f32x4 (&acc)[2][2][4][2], const Unit& u, int wr, int wc, int fr, int fq) const {
#pragma unroll
        for (int ai = 0; ai < 2; ++ai)
#pragma unroll
            for (int m = 0; m < 4; ++m) {
                const int row = u.pm * BM + ai * HALF + wr * 64 + m * 16 + fr;
#pragma unroll
                for (int bj = 0; bj < 2; ++bj) {
                    const int col = bj * HALF + wc * 32 + 8 * fq;
                    f32x4 a = acc[ai][bj][m][0], b = acc[ai][bj][m][1];
                    if (ACT == 1) {
#pragma unroll
                        for (int i = 0; i < 4; ++i) { a[i] = gelu_tanh(a[i]); b[i] = gelu_tanh(b[i]); }
                    }
                    u32x4 w; w.x = pkh(a.x, a.y); w.y = pkh(a.z, a.w); w.z = pkh(b.x, b.y); w.w = pkh(b.z, b.w);
                    *(GAS u32x4*)(O + (size_t)row * 256 + col) = w;
                    asm volatile("" ::: "memory"); __builtin_amdgcn_sched_barrier(0);
                }
            }
    }
};

template <class Epi, class Sched, bool ALIGN_EPI = false, bool SP2 = false>
__device__ __forceinline__ void gemm_phase(LAS unsigned char* lds, const int tid, const Gemm g, const Sched& S, const Epi& E) {
    const int wid = __builtin_amdgcn_readfirstlane(tid >> 6), lane = tid & 63, wr = wid >> 2, wc = wid & 3, fr = lane & 15, fq = lane >> 4;
    const int K = g.K, nt = K / BK;
    unsigned voffA[2], voffB[2];
#pragma unroll
    for (int i = 0; i < 2; ++i) { int R, C; stage_rc(tid * 16 + i * 8192, R, C); const int Rb = Epi::PERM ? ((R & ~31) + perm32(R & 31)) : R;
        voffA[i] = (unsigned)(R * K + C) * 2u; voffB[i] = (unsigned)(Rb * K + C) * 2u; }
    const size_t kstep = (size_t)(BK * 2);
    const size_t hstep = (size_t)HALF * K * 2;
    const size_t tstep = 2 * hstep;
    const unsigned ldsw = (unsigned)wid * 1024u;
    const int aoff = lds_byte(wr * 64 + fr, fq * 8), boff = lds_byte(wc * 32 + fr, fq * 8);
#define PG8_SA(b, h) (((b) * 2 + (h)) * HTB)
#define PG8_SB(b, h) ((4 + (b) * 2 + (h)) * HTB)
#define PG8_STAGE(bufoff, gbase, voff) do { _Pragma("unroll") for (int _i = 0; _i < 2; ++_i) \
        __builtin_amdgcn_global_load_lds((const unsigned*)((const char*)(gbase) + (voff)[_i]), (LAS unsigned*)(lds + (bufoff) + ldsw + _i * 8192), 16, 0, 0); } while (0)
#define PG8_LDA(dst, b, h) do { _Pragma("unroll") for (int m = 0; m < 4; ++m) _Pragma("unroll") for (int k = 0; k < 2; ++k) dst[m][k] = *(const LAS half8*)(lds + PG8_SA(b, h) + aoff + m * 2048 + k * 1024); } while (0)
#define PG8_LDB(dst, b, h) do { _Pragma("unroll") for (int n = 0; n < 2; ++n) _Pragma("unroll") for (int k = 0; k < 2; ++k) dst[n][k] = *(const LAS half8*)(lds + PG8_SB(b, h) + boff + n * 2048 + k * 1024); } while (0)
#define PG8_MMA(ai, bj, At, Bt) do { __builtin_amdgcn_s_setprio(1); _Pragma("unroll") for (int m = 0; m < 4; ++m) _Pragma("unroll") for (int n = 0; n < 2; ++n) _Pragma("unroll") for (int k = 0; k < 2; ++k) \
        acc[ai][bj][m][n] = __builtin_amdgcn_mfma_f32_16x16x32_f16(Bt[n][k], At[m][k], acc[ai][bj][m][n], 0, 0, 0); __builtin_amdgcn_s_setprio(0); } while (0)
#define PG8_WAIT_V(n) asm volatile("s_waitcnt vmcnt(" #n ")" ::: "memory")
#define PG8_WAIT_L(n) asm volatile("s_waitcnt lgkmcnt(" #n ")" ::: "memory")
#define PG8_BAR __builtin_amdgcn_s_barrier()
#define PG8_SCHED __builtin_amdgcn_sched_barrier(0)
    Unit cur, nxt; int ui = 0;
    if (!S.next(0, cur)) return;
    f32x4 acc[2][2][4][2];
#pragma unroll
    for (int a = 0; a < 2; ++a)
#pragma unroll
        for (int b = 0; b < 2; ++b)
#pragma unroll
            for (int m = 0; m < 4; ++m)
#pragma unroll
                for (int n = 0; n < 2; ++n) acc[a][b][m][n] = (f32x4){0.f, 0.f, 0.f, 0.f};
    half8 At[4][2], B0[2][2], B1[2][2];
    const char* cA = (const char*)g.A + (size_t)cur.pm * tstep; const char* cB = (const char*)g.Bt + (size_t)cur.pn * tstep;
    if constexpr (SP2) {
        PG8_STAGE(PG8_SB(0, 0), cB, voffB); PG8_STAGE(PG8_SB(0, 1), cB + hstep, voffB); PG8_STAGE(PG8_SA(0, 0), cA, voffA); PG8_STAGE(PG8_SA(0, 1), cA + hstep, voffA);
        if (wr == 1) PG8_BAR;
        PG8_WAIT_V(2); PG8_BAR;
        PG8_STAGE(PG8_SB(1, 0), cB + kstep, voffB); PG8_STAGE(PG8_SA(1, 0), cA + kstep, voffA); PG8_STAGE(PG8_SB(1, 1), cB + hstep + kstep, voffB);
        PG8_WAIT_V(6); PG8_BAR;
    } else {
        PG8_STAGE(PG8_SB(0, 0), cB, voffB); PG8_STAGE(PG8_SA(0, 0), cA, voffA); PG8_STAGE(PG8_SB(0, 1), cB + hstep, voffB); PG8_STAGE(PG8_SA(0, 1), cA + hstep, voffA);
        if (wr == 1) PG8_BAR;
        PG8_WAIT_V(4); PG8_BAR;
        PG8_STAGE(PG8_SB(1, 0), cB + kstep, voffB); PG8_STAGE(PG8_SA(1, 0), cA + kstep, voffA); PG8_STAGE(PG8_SB(1, 1), cB + hstep + kstep, voffB);
        PG8_WAIT_V(6); PG8_BAR;
    }
    for (;;) {
        const bool has_next = S.next(ui + 1, nxt);
        const char* nA = has_next ? (const char*)g.A + (size_t)nxt.pm * tstep : cA; const char* nB = has_next ? (const char*)g.Bt + (size_t)nxt.pn * tstep : cB;
        for (int t = 0; t < nt; t += 2) {
            const bool last = (t == nt - 2);
            const char* a1 = cA + (size_t)(t + 1) * kstep;
            const char* a2 = last ? nA : cA + (size_t)(t + 2) * kstep; const char* b2 = last ? nB : cB + (size_t)(t + 2) * kstep;
            const char* a3 = a2 + kstep; const char* b3 = b2 + kstep;
            if constexpr (SP2) {
            PG8_LDB(B0, 0, 0); PG8_LDB(B1, 0, 1); PG8_SCHED; PG8_LDA(At, 0, 0); PG8_STAGE(PG8_SA(1, 1), a1 + hstep, voffA);
            PG8_WAIT_V(8); PG8_WAIT_L(0); PG8_BAR; PG8_MMA(0, 0, At, B0); PG8_MMA(0, 1, At, B1); PG8_BAR; PG8_SCHED;
            PG8_LDA(At, 0, 1); PG8_STAGE(PG8_SB(0, 0), b2, voffB); PG8_STAGE(PG8_SB(0, 1), b2 + hstep, voffB); PG8_STAGE(PG8_SA(0, 0), a2, voffA);
            PG8_WAIT_V(8); PG8_WAIT_L(0); PG8_BAR; PG8_MMA(1, 0, At, B0); PG8_MMA(1, 1, At, B1); PG8_BAR; PG8_SCHED;
            PG8_LDB(B0, 1, 0); PG8_LDB(B1, 1, 1); PG8_SCHED; PG8_LDA(At, 1, 0); PG8_STAGE(PG8_SA(0, 1), a2 + hstep, voffA);
            PG8_WAIT_V(8); PG8_WAIT_L(0); PG8_BAR; PG8_MMA(0, 0, At, B0); PG8_MMA(0, 1, At, B1); PG8_BAR; PG8_SCHED;
            PG8_LDA(At, 1, 1); PG8_STAGE(PG8_SB(1, 0), b3, voffB); PG8_STAGE(PG8_SB(1, 1), b3 + hstep, voffB); PG8_STAGE(PG8_SA(1, 0), a3, voffA);
            PG8_WAIT_V(8); PG8_WAIT_L(0); PG8_BAR; PG8_MMA(1, 0, At, B0); PG8_MMA(1, 1, At, B1); PG8_BAR; PG8_SCHED;
            } else {
            PG8_LDB(B0, 0, 0); PG8_SCHED; PG8_LDA(At, 0, 0); PG8_STAGE(PG8_SA(1, 1), a1 + hstep, voffA);
            PG8_WAIT_L(8); PG8_BAR; PG8_WAIT_L(0); PG8_MMA(0, 0, At, B0); PG8_BAR; PG8_SCHED;
            PG8_LDB(B1, 0, 1); PG8_STAGE(PG8_SB(0, 0), b2, voffB);
            PG8_BAR; PG8_WAIT_L(0); PG8_MMA(0, 1, At, B1); PG8_BAR;
            PG8_LDA(At, 0, 1); PG8_STAGE(PG8_SA(0, 0), a2, voffA);
            PG8_BAR; PG8_WAIT_L(0); PG8_MMA(1, 0, At, B0); PG8_BAR; PG8_SCHED;
            PG8_STAGE(PG8_SB(0, 1), b2 + hstep, voffB);
            PG8_WAIT_V(6); PG8_BAR; PG8_MMA(1, 1, At, B1); PG8_BAR;
            PG8_LDB(B0, 1, 0); PG8_SCHED; PG8_LDA(At, 1, 0); PG8_STAGE(PG8_SA(0, 1), a2 + hstep, voffA);
            PG8_WAIT_L(8); PG8_BAR; PG8_WAIT_L(0); PG8_MMA(0, 0, At, B0); PG8_BAR; PG8_SCHED;
            PG8_LDB(B1, 1, 1); PG8_STAGE(PG8_SB(1, 0), b3, voffB);
            PG8_BAR; PG8_WAIT_L(0); PG8_MMA(0, 1, At, B1); PG8_BAR;
            PG8_LDA(At, 1, 1); PG8_STAGE(PG8_SA(1, 0), a3, voffA);
            PG8_BAR; PG8_WAIT_L(0); PG8_MMA(1, 0, At, B0); PG8_BAR; PG8_SCHED;
            PG8_STAGE(PG8_SB(1, 1), b3 + hstep, voffB);
            PG8_WAIT_V(6); PG8_BAR; PG8_MMA(1, 1, At, B1); PG8_BAR;
            }
        }
        if constexpr (ALIGN_EPI) { if (wr == 0) PG8_BAR; }
        E(acc, cur, wr, wc, fr, fq);
        if (!has_next) break;
#pragma unroll
        for (int a = 0; a < 2; ++a)
#pragma unroll
            for (int b = 0; b < 2; ++b)
#pragma unroll
                for (int m = 0; m < 4; ++m)
#pragma unroll
                    for (int n = 0; n < 2; ++n) acc[a][b][m][n] = (f32x4){0.f, 0.f, 0.f, 0.f};
        cur = nxt; cA = nA; cB = nB; ++ui;
        if constexpr (ALIGN_EPI) { if (wr == 1) PG8_BAR; }
    }
    PG8_WAIT_V(0);
    if constexpr (!ALIGN_EPI) { if (wr == 0) PG8_BAR; }
    PG8_BAR;
#undef PG8_SA
#undef PG8_SB
#undef PG8_STAGE
#undef PG8_LDA
#undef PG8_LDB
#undef PG8_MMA
#undef PG8_WAIT_V
#undef PG8_WAIT_L
#undef PG8_BAR
#undef PG8_SCHED
}
}

constexpr size_t MiB = 1u << 20;
constexpr size_t WS_CTL = 0, CTL_ZERO_BYTES = 64 * 1024;
constexpr size_t WS_COS = 1 * MiB, WS_SIN = 1 * MiB + 512 * 1024;
constexpr size_t WS_PSUM = 2 * MiB;
constexpr size_t WS_WIN = 4 * MiB, WS_WOUT = 10 * MiB, WS_WUP = 12 * MiB, WS_WDN = 20 * MiB, WS_WC1 = 28 * MiB, WS_WC2 = 30 * MiB;
constexpr size_t WS_X16 = 32 * MiB;
constexpr size_t WS_O16 = 64 * MiB;
constexpr size_t WS_P = 96 * MiB;
constexpr size_t WS_U = 96 * MiB;
constexpr size_t WS_AC = 168 * MiB;
constexpr size_t WS_HC = 184 * MiB;
constexpr size_t WS_KVC = 186 * MiB;
constexpr size_t WS_MASK = 188 * MiB;
constexpr size_t WS_KIF = 196 * MiB;
constexpr size_t WS_END = 224 * MiB;
constexpr int CW_BAR = 1024;

constexpr int RING_BYTES = 131072, WSCR_OFF = 131072, LDSCTL_OFF = 139264, MISC_OFF = LDSCTL_OFF + 64, LDS_BYTES = 147456;

#define XB_TMO      128
#define XB_XCNT(j)  (256  + 64 * (j))
#define XB_XSUB(j)  (1280 + 64 * (j))
#define XB_XGEN(j)  (2304 + 64 * (j))
#define XB_TOP      3328
#define XB_TOPGEN   3392
#define XCD_BAR_WORDS 3456
#define XB_SPIN_CAP (1u << 20)
__device__ __forceinline__ unsigned xb_ld(unsigned* p)              { return __hip_atomic_load(p, __ATOMIC_RELAXED, __HIP_MEMORY_SCOPE_AGENT); }
__device__ __forceinline__ unsigned xb_add(unsigned* p, unsigned v) { return __hip_atomic_fetch_add(p, v, __ATOMIC_RELAXED, __HIP_MEMORY_SCOPE_AGENT); }
__device__ __forceinline__ unsigned xb_xcc_id() { return (unsigned)__builtin_amdgcn_s_getreg((3 << 11) | 20) & 0xFu; }
#define XB_SPIN(cond, bar) do { unsigned _sp = 0; while (cond) { __builtin_amdgcn_s_sleep(1); \
    if ((++_sp & 255u) == 0u) { if (xb_ld(&(bar)[XB_TMO])) break; if (_sp > XB_SPIN_CAP) { atomicAdd(&(bar)[XB_TMO], 1u); break; } } } } while (0)
struct XcdBarrier { unsigned* bar; unsigned x; volatile LAS unsigned* st; };
__device__ __forceinline__ XcdBarrier xcd_barrier_post(unsigned* bar, volatile LAS unsigned* st) {
    XcdBarrier b; b.bar = bar; b.x = xb_xcc_id(); b.st = st;
    if (threadIdx.x == 0) (void)xb_add(&bar[XB_XCNT(b.x)], 1u);
    return b;
}
__device__ __forceinline__ void xcd_barrier_complete(unsigned* bar, unsigned x, unsigned& nloc, unsigned& nx) {
    const unsigned G = gridDim.x * gridDim.y * gridDim.z;
    unsigned sum, cnt, mine, sp = 0u;
    for (;;) {
        sum = 0u; cnt = 0u; mine = 0u;
#pragma unroll
        for (unsigned j = 0; j < 16; ++j) { const unsigned c = xb_ld(&bar[XB_XCNT(j)]); sum += c; cnt += (c > 0u) ? 1u : 0u; mine = (j == x) ? c : mine; }
        if (sum == G) break;
        __builtin_amdgcn_s_sleep(1);
        if ((++sp & 255u) == 0u) { if (xb_ld(&bar[XB_TMO])) break; if (sp > XB_SPIN_CAP) { atomicAdd(&bar[XB_TMO], 1u); break; } }
    }
    nloc = mine > 0u ? mine : 1u; nx = cnt > 0u ? cnt : 1u;
}
__device__ __forceinline__ void xcd_barrier(const XcdBarrier& b) {
    asm volatile("s_waitcnt vmcnt(0)" ::: "memory");
    __syncthreads();
    if (threadIdx.x == 0) {
        unsigned* bar = b.bar; asm volatile("" : "+s"(bar));
        __builtin_amdgcn_s_waitcnt(0);
        unsigned nloc = b.st[0], nx = b.st[1];
        if (nloc == 0u) { xcd_barrier_complete(bar, b.x, nloc, nx); b.st[0] = nloc; b.st[1] = nx; }
        const unsigned old = xb_add(&bar[XB_XSUB(b.x)], 1u);
        const unsigned gen = old / nloc;
        if (old + 1u == (gen + 1u) * nloc) {
            __builtin_amdgcn_fence(__ATOMIC_RELEASE, "agent");
            asm volatile("s_waitcnt vmcnt(0)" ::: "memory");
            const unsigned og = xb_add(&bar[XB_TOP], 1u);
            const unsigned tg = og / nx;
            if (og + 1u == (tg + 1u) * nx) xb_add(&bar[XB_TOPGEN], 1u);
            else XB_SPIN(xb_ld(&bar[XB_TOPGEN]) == tg, bar);
            __builtin_amdgcn_fence(__ATOMIC_ACQUIRE, "agent");
            xb_add(&bar[XB_XGEN(b.x)], 1u);
            asm volatile("s_waitcnt vmcnt(0)" ::: "memory");
        } else {
            XB_SPIN(xb_ld(&bar[XB_XGEN(b.x)]) == gen, bar);
            __builtin_amdgcn_fence(__ATOMIC_ACQUIRE, "agent");
            asm volatile("s_waitcnt vmcnt(0)" ::: "memory");
        }
    }
    __syncthreads();
}

struct Args {
    const float* x; const float* mix_g; const float* mlp_g; const float* even_w_in; const float* even_pe; const float* even_w1; const float* even_w2; const float* even_w_out;
    const float* odd_w_in; const float* odd_lambda; const float* odd_subln; const float* odd_w_out; const float* mlp_up; const float* mlp_down; const float* final_g;
    float* out; unsigned char* ws; int ph_lo, ph_hi;
};
typedef const __attribute__((address_space(4))) Args* ArgsP;
struct Frame {
    LAS unsigned char* lds; int tid, lane, wave, G, bid;
    ArgsP a; unsigned char* ws;
};
__device__ __forceinline__ ArgsP kargs() { ArgsP p = (ArgsP)__builtin_amdgcn_kernarg_segment_ptr(); asm volatile("" : "+s"(p)); return p; }

enum { K_PREP = 0, K_INPROJ, K_PRE, K_CMP1, K_CMP2, K_ATTN, K_OUTPROJ, K_UP, K_DOWN, K_FINAL };
constexpr int NPHASE = 29;
__host__ __device__ __forceinline__ void phase_decode(int ph, int& layer, int& kind) {
    if (ph >= 28) { layer = 4; kind = K_FINAL; return; }
    int base;
    if (ph < 8) { layer = 0; base = 0; } else if (ph < 14) { layer = 1; base = 8; } else if (ph < 22) { layer = 2; base = 14; } else { layer = 3; base = 22; }
    const int i = ph - base;
    if (layer & 1) kind = (i == 0) ? K_PREP : (i == 1) ? K_INPROJ : (i == 2) ? K_ATTN : (i == 3) ? K_OUTPROJ : (i == 4) ? K_UP : K_DOWN;
    else kind = (i < 4) ? i : i + 1;
}

__device__ __forceinline__ int storage_row(int c) {
    const int head = c >> 6, d = c & 63;
    const int s = (d < 32) ? ((d >> 2) * 8 + (d & 3)) : (((d - 32) >> 2) * 8 + 4 + (d & 3));
    return head * 64 + s;
}
template <int MAP>
__device__ __forceinline__ void conv_weight(const Frame& F, const float* src, int K, int N, u16* dst, const float* gain) {
    const int gtid = F.bid * 512 + F.tid, GT = F.G * 512;
    const int total = N * (K / 8);
    for (int i0 = gtid; i0 < total; i0 += 2 * GT) {
        float v[2][8]; int nn[2], kk[2]; bool ok[2];
#pragma unroll
        for (int c = 0; c < 2; ++c) { const int i = i0 + c * GT; ok[c] = i < total; const int ii = ok[c] ? i : i0; nn[c] = ii % N; kk[c] = (ii / N) * 8;
#pragma unroll
            for (int j = 0; j < 8; ++j) v[c][j] = ((const GAS float*)src)[(size_t)(kk[c] + j) * N + nn[c]]; }
#pragma unroll
        for (int c = 0; c < 2; ++c) {
            if (gain) {
#pragma unroll
                for (int j = 0; j < 8; ++j) v[c][j] *= ((const GAS float*)gain)[kk[c] + j]; }
            int r = nn[c];
            if (MAP == 1) { int cc = nn[c];
                if (cc >= 960 && cc < 964) cc = cc - 960 + C_WI;
                else if (cc >= 964 && cc < 1476) cc = cc - 4;
                else if (cc >= 1476 && cc < 2244) { const int j = cc - 1476, idx = j >> 7, gg = (j >> 6) & 1, d = j & 63;
                    cc = (idx < 4) ? (C_KVB + j) : (idx == 4) ? ((gg ? C_KW1 : C_KW0) + d) : (C_VW + gg * 64 + d); }
                else if (cc >= 2244) cc = cc - 2244 + C_GB;
                r = storage_row(cc); }
            if (MAP == 2) r = storage_row(nn[c]);
            u32x4 w; w.x = pkh(v[c][0], v[c][1]); w.y = pkh(v[c][2], v[c][3]); w.z = pkh(v[c][4], v[c][5]); w.w = pkh(v[c][6], v[c][7]);
            if (ok[c]) *(GAS u32x4*)(dst + (size_t)r * K + kk[c]) = w;
        }
    }
}

__device__ __forceinline__ void prep_phase(const Frame& F, int layer) {
    const ArgsP ap = F.a; unsigned char* ws = F.ws;
    const int gtid = F.bid * 512 + F.tid, GT = F.G * 512;
    if (layer == 0) {
        float* cosT = (float*)(ws + WS_COS); float* sinT = (float*)(ws + WS_SIN);
        for (int i = gtid; i < T * 32; i += GT) {
            const int t = i >> 5, k = i & 31;
            const float ang = (float)t * ROPE_INV[k];
            double r = (double)ang * 0.15915494309189535; r -= rint(r);
            cosT[i] = __builtin_amdgcn_cosf((float)r); sinT[i] = __builtin_amdgcn_sinf((float)r);
        }
        const int gw = F.bid * 8 + F.wave, NGW = F.G * 8;
        float* psum = (float*)(ws + WS_PSUM); u16* x16 = (u16*)(ws + WS_X16);
        for (int row = gw; row < M; row += NGW) {
            const f32x4* xr = (const f32x4*)(G(ap->x) + (size_t)row * DM) + F.lane;
            u32x2* hrow = (u32x2*)(x16 + (size_t)row * DM) + F.lane;
            float s = 0.f;
#pragma unroll
            for (int j = 0; j < 4; ++j) { const f32x4 v = xr[64 * j]; s += (v.x * v.x + v.y * v.y) + (v.z * v.z + v.w * v.w);
                u32x2 w; w.x = pkh(v.x, v.y); w.y = pkh(v.z, v.w); hrow[64 * j] = w; }
            s = wave_sum(s);
            if (F.lane < 16) psum[(size_t)row * 16 + F.lane] = (F.lane == 0) ? s : 0.f;
        }
    }
    const int e = layer >> 1;
    if (layer & 1) {
        conv_weight<2>(F, G(ap->odd_w_in) + (size_t)e * DM * ODD_N, DM, ODD_N, (u16*)(ws + WS_WIN), G(ap->mix_g) + layer * DM);
        conv_weight<0>(F, G(ap->odd_w_out) + (size_t)e * DM * DM, DM, DM, (u16*)(ws + WS_WOUT), nullptr);
    } else {
        conv_weight<1>(F, G(ap->even_w_in) + (size_t)e * DM * 2268, DM, 2268, (u16*)(ws + WS_WIN), G(ap->mix_g) + layer * DM);
        conv_weight<0>(F, G(ap->even_w_out) + (size_t)e * DM * DM, DM, DM, (u16*)(ws + WS_WOUT), nullptr);
        conv_weight<0>(F, G(ap->even_w1) + (size_t)(e * 2 + 0) * 2048 * 256, 2048, 256, (u16*)(ws + WS_WC1), nullptr);
        conv_weight<0>(F, G(ap->even_w1) + (size_t)(e * 2 + 1) * 2048 * 256, 2048, 256, (u16*)(ws + WS_WC1) + (size_t)256 * 2048, nullptr);
        conv_weight<0>(F, G(ap->even_w2) + (size_t)(e * 2 + 0) * 256 * 64, 256, 64, (u16*)(ws + WS_WC2), nullptr);
        conv_weight<0>(F, G(ap->even_w2) + (size_t)(e * 2 + 1) * 256 * 64, 256, 64, (u16*)(ws + WS_WC2) + (size_t)256 * 256, nullptr);
    }
    conv_weight<0>(F, G(ap->mlp_up) + (size_t)layer * DM * DFF, DM, DFF, (u16*)(ws + WS_WUP), G(ap->mlp_g) + layer * DM);
    conv_weight<0>(F, G(ap->mlp_down) + (size_t)layer * DFF * DM, DFF, DM, (u16*)(ws + WS_WDN), nullptr);
}

__device__ __forceinline__ unsigned sortable(float f) {
    if (f == 0.f) f = 0.f;
    const unsigned b = __float_as_uint(f);
    return (b & 0x80000000u) ? ~b : (b | 0x80000000u);
}
__device__ __forceinline__ int wave_isum(int v) {
#pragma unroll
    for (int o = 1; o < 64; o <<= 1) v += __shfl_xor(v, o);
    return v;
}
__device__ __forceinline__ void select_row(LAS unsigned* ub, int t, u64* maskrow, int lane, LAS unsigned* wscr) {
    unsigned u[64];
#pragma unroll
    for (int j = 0; j < 64; ++j) { const int s = j * 64 + lane; const unsigned v = ub[s]; u[j] = (s <= t) ? v : 0u; }
    const int n = t + 1;
    unsigned L = 1u;
    if (n > 704) {
        int ns = 0;
#pragma unroll
        for (int i = 0; i < 8; ++i) { int c = n - 512 * i; c = c < 0 ? 0 : (c > 64 ? 64 : c); ns += c; }
        const int cs_lo = (380 * ns + n - 1) / n, cs_hi = (620 * ns) / n;
        unsigned ts = 0u;
        for (int bit = 31; bit >= 0; --bit) {
            const unsigned cand = ts | (1u << bit);
            int cs = 0;
#pragma unroll
            for (int i = 0; i < 8; ++i) cs += __popcll(__ballot(u[8 * i] >= cand));
            if (cs >= cs_lo) { ts = cand; if (cs <= cs_hi) break; }
        }
        L = ts > 1u ? ts : 1u;
    }
    int C = 0;
    asm volatile("s_waitcnt lgkmcnt(0)" ::: "memory");
#pragma unroll
    for (int j = 0; j < 64; ++j) {
        const bool pr = u[j] >= L; const u64 bal = __ballot(pr);
        const int pos = C + (int)__builtin_amdgcn_mbcnt_hi((unsigned)(bal >> 32), __builtin_amdgcn_mbcnt_lo((unsigned)bal, 0u));
        ub[(pr && pos < 704) ? pos : 704 + lane] = u[j];
        C += __popcll(bal);
    }
    asm volatile("s_waitcnt lgkmcnt(0)" ::: "memory");
    unsigned thr = 0u; int need;
    if (C >= 256 && C <= 704) {
        unsigned v[11];
#pragma unroll
        for (int i = 0; i < 11; ++i) { const int p = i * 64 + lane; const unsigned x = ub[p]; v[i] = (p < C) ? x : 0u; }
        bool exact = false;
        for (int bit = 31; bit >= 0; --bit) {
            const unsigned cand = thr | (1u << bit);
            int cnt = 0;
#pragma unroll
            for (int i = 0; i < 11; ++i) cnt += __popcll(__ballot(v[i] >= cand));
            if (cnt >= 256) { thr = cand; if (cnt == 256) { exact = true; break; } }
        }
        if (exact) need = 1 << 20;
        else { int cg = 0, cge = 0;
#pragma unroll
            for (int i = 0; i < 11; ++i) { cg += __popcll(__ballot(v[i] > thr)); cge += __popcll(__ballot(v[i] >= thr)); }
            need = (cge == 256) ? (1 << 20) : 256 - cg; }
    } else {
        bool exact = false;
        for (int bit = 31; bit >= 0; --bit) {
            const unsigned cand = thr | (1u << bit);
            int c0 = 0, c1 = 0;
#pragma unroll
            for (int j = 0; j < 64; j += 2) { c0 += (u[j] >= cand) ? 1 : 0; c1 += (u[j + 1] >= cand) ? 1 : 0; }
            const int cnt = wave_isum(c0 + c1);
            if (cnt >= 256) { thr = cand; if (cnt == 256) { exact = true; break; } }
        }
        if (exact) need = 1 << 20;
        else { int cg = 0, cge = 0;
#pragma unroll
            for (int j = 0; j < 64; ++j) { cg += (u[j] > thr) ? 1 : 0; cge += (u[j] >= thr) ? 1 : 0; }
            need = (wave_isum(cge) == 256) ? (1 << 20) : 256 - wave_isum(cg); }
    }
    unsigned wlo = 0u, whi = 0u;
    if (need >= (1 << 20)) {
#pragma unroll
        for (int j = 0; j < 64; ++j) { const u64 ge = __ballot(u[j] >= thr); const unsigned glo = (unsigned)ge, ghi = (unsigned)(ge >> 32);
            asm volatile("s_nop 1\n\tv_writelane_b32 %0, %2, %4\n\tv_writelane_b32 %1, %3, %4" : "+v"(wlo), "+v"(whi) : "s"(glo), "s"(ghi), "i"(j)); }
    } else {
#pragma unroll
        for (int j = 0; j < 64; ++j) {
            const u64 gt = __ballot(u[j] > thr);
            u64 eq = __ballot(u[j] == thr);
            int c = __popcll(eq);
            while (c > need) { eq &= ~(1ull << (63 - __clzll(eq))); --c; }
            need -= c;
            const u64 w = gt | eq;
            wlo = (lane == j) ? (unsigned)w : wlo; whi = (lane == j) ? (unsigned)(w >> 32) : whi;
        }
    }
    ((GAS u64*)maskrow)[lane] = ((u64)whi << 32) | wlo;
}

template <int DV, class Valid>
__device__ __forceinline__ void naive_attn(const u16* qp, const u16* Kb, int kp, const u16* Vb, int vp, int s_lo, int s_hi, Valid valid, LAS float* pbuf, int lane, float (&o)[DV / 64], float& inv) {
    float q[64];
#pragma unroll
    for (int c = 0; c < 8; ++c) unpack8(*(const GAS u32x4*)(qp + c * 8), q + c * 8);
    const int base = s_lo & ~63;
    float mx = -INFINITY;
    for (int s0 = base; s0 <= s_hi; s0 += 64) {
        const int s = s0 + lane; float sc = -INFINITY;
        if (s >= s_lo && s <= s_hi && valid(s)) {
            const u32x4* kr = (const u32x4*)(Kb + (size_t)s * kp); sc = 0.f;
#pragma unroll
            for (int c = 0; c < 8; ++c) { float kf[8]; unpack8(kr[c], kf);
#pragma unroll
                for (int i = 0; i < 8; ++i) sc += q[c * 8 + i] * kf[i]; }
        }
        pbuf[s - base] = sc; mx = fmaxf(mx, sc);
    }
    mx = wave_max(mx);
#pragma unroll
    for (int i = 0; i < DV / 64; ++i) o[i] = 0.f;
    inv = 0.f;
    if (mx == -INFINITY) return;
    float sum = 0.f; u64 anym = 0ull;
    for (int s0 = base; s0 <= s_hi; s0 += 64) {
        const float p = __builtin_amdgcn_exp2f(pbuf[s0 - base + lane] - mx);
        pbuf[s0 - base + lane] = p; sum += p;
        if (__ballot(p > 0.f)) anym |= 1ull << ((s0 - base) >> 6);
    }
    sum = wave_sum(sum); inv = 1.0f / sum;
    const int nch = ((s_hi - base) >> 6) + 1;
    for (int ch = 0; ch < nch; ++ch) {
        if (!((anym >> ch) & 1ull)) continue;
        const LAS float* pp = pbuf + ch * 64; const u16* vr = Vb + (size_t)(base + ch * 64) * vp + lane;
#pragma unroll 8
        for (int i = 0; i < 64; ++i) {
            const float p = pp[i];
#pragma unroll
            for (int j = 0; j < DV / 64; ++j) o[j] += p * h2f(vr[(size_t)i * vp + 64 * j]);
        }
    }
#pragma unroll
    for (int i = 0; i < DV / 64; ++i) o[i] *= inv;
}

__device__ __forceinline__ void idx_unit(const Frame& F, int b, int qb8) {
    typedef float f32x16_ __attribute__((ext_vector_type(16)));
    const int lane = F.lane, wave = F.wave, r32 = lane & 31, hi = lane >> 5;
    unsigned char* ws = F.ws;
    const u16* Pb = (const u16*)(ws + WS_P) + (size_t)b * T * EVEN_N;
    u64* MASK = (u64*)(ws + WS_MASK) + (size_t)(b * T) * 64;
    const u16* KIF = (const u16*)(ws + WS_KIF);
    const int t0 = qb8 * 8;
    if (t0 + 7 < 256) {
        const int t = t0 + wave, w = lane; u64 v;
        if (64 * w + 63 <= t) v = ~0ull; else if (64 * w > t) v = 0ull; else v = (1ull << (t - 64 * w + 1)) - 1ull;
        ((GAS u64*)MASK)[(size_t)t * 64 + w] = v; return;
    }
    LAS unsigned* ub = (LAS unsigned*)F.lds;
    half8 qa[4];
    { const u16* qp = Pb + (size_t)(t0 + (r32 >> 2)) * EVEN_N + C_QI + (r32 & 3) * 64 + hi * 8;
#pragma unroll
      for (int ks = 0; ks < 4; ++ks) qa[ks] = *(const GAS half8*)(qp + ks * 16); }
    float wq[4][4];
#pragma unroll
    for (int i = 0; i < 4; ++i) { const u32x2 w2 = *(const GAS u32x2*)(Pb + (size_t)(t0 + 2 * i + hi) * EVEN_N + C_WI);
        wq[i][0] = h2f(w2.x & 0xffffu); wq[i][1] = h2f(w2.x >> 16); wq[i][2] = h2f(w2.y & 0xffffu); wq[i][3] = h2f(w2.y >> 16); }
    const int nt32 = ((t0 + 7) >> 5) + 1;
    for (int kt0 = wave; kt0 < nt32; kt0 += 64) {
        half8 kb[8][4];
#pragma unroll
        for (int u = 0; u < 8; ++u) { const int kt = (kt0 + 8 * u < nt32) ? kt0 + 8 * u : kt0;
            const u16* kp = KIF + ((size_t)(b * (T / 32) + kt) * 8 * 32 + lane) * 8;
#pragma unroll
            for (int ks = 0; ks < 4; ++ks) kb[u][ks] = *(const GAS half8*)(kp + (size_t)ks * 64 * 8); }
#pragma unroll
        for (int u = 0; u < 8; ++u) {
            const int kt = kt0 + 8 * u;
            if (kt < nt32) {
                f32x16_ c = {0.f, 0.f, 0.f, 0.f, 0.f, 0.f, 0.f, 0.f, 0.f, 0.f, 0.f, 0.f, 0.f, 0.f, 0.f, 0.f};
#pragma unroll
                for (int ks = 0; ks < 4; ++ks) c = __builtin_amdgcn_mfma_f32_32x32x16_f16(qa[ks], kb[u][ks], c, 0, 0, 0);
#pragma unroll
                for (int i = 0; i < 4; ++i) {
                    const float sc = wq[i][0] * fmaxf(c[4 * i], 0.f) + wq[i][1] * fmaxf(c[4 * i + 1], 0.f) + wq[i][2] * fmaxf(c[4 * i + 2], 0.f) + wq[i][3] * fmaxf(c[4 * i + 3], 0.f);
                    ub[(2 * i + hi) * 4096 + kt * 32 + r32] = sortable(sc);
                }
            }
        }
    }
    __syncthreads();
    select_row(ub + wave * 4096, t0 + wave, MASK + (size_t)(t0 + wave) * 64, lane, (LAS unsigned*)(F.lds + WSCR_OFF + wave * 1024));
    __syncthreads();
}

__device__ __forceinline__ void pre_phase(const Frame& F, int layer) {
    const ArgsP ap = F.a; unsigned char* ws = F.ws; const int e = layer >> 1;
    const u16* P = (const u16*)(ws + WS_P);
    const int gtid = F.bid * 512 + F.tid, GT = F.G * 512;
    u16* AC = (u16*)(ws + WS_AC);
    for (int i = gtid; i < 2 * 4 * 2 * 256 * 256; i += GT) {
        const int ch = i & 255, n = (i >> 8) & 255, g = (i >> 16) & 1, b = (i >> 17) & 3, kv = i >> 19;
        const int l = ch >> 3, d0 = (ch & 7) * 8;
        u32x4 w = (u32x4){0u, 0u, 0u, 0u};
        if (n < 255) {
            float f[8]; unpack8(*(const GAS u32x4*)(P + (size_t)(b * T + 16 * n + l) * EVEN_N + C_KC + kv * 128 + g * 64 + d0), f);
            const float* pe = G(ap->even_pe) + ((size_t)(e * 2 + kv) * 32 + l) * 64 + d0;
#pragma unroll
            for (int j = 0; j < 8; ++j) f[j] += pe[j];
            w.x = pkh(f[0], f[1]); w.y = pkh(f[2], f[3]); w.z = pkh(f[4], f[5]); w.w = pkh(f[6], f[7]);
        }
        *(GAS u32x4*)(AC + (size_t)i * 8) = w;
    }
    __syncthreads();
    if (F.G == 256) { for (int i = 0; i < 8; ++i) idx_unit(F, i >> 1, (i & 1) ? 511 - F.bid : F.bid); }
}

typedef float f32x16 __attribute__((ext_vector_type(16)));
typedef short v4i16 __attribute__((ext_vector_type(4)));
constexpr int A_KB = 0, A_VB = 32768, A_AUX = 65536;
constexpr float NEG_BIG = -1.0e30f;
__device__ __forceinline__ constexpr int crow(int r, int hi) { return (r & 3) + 8 * (r >> 2) + 4 * hi; }

template <int KD> __device__ __forceinline__ int kswz(int row, int chunk) { return (KD == 64) ? (chunk ^ ((row >> 1) & 7)) : (chunk ^ (row & 15)); }
template <int KD> __device__ __forceinline__ void stage_load_k(u32x4 (&kr)[KD / 64], const u16* Kg, int pitch, int tid) {
#pragma unroll
    for (int i = 0; i < KD / 64; ++i) { const int p = tid + 512 * i, row = p / (KD / 8), ch = p % (KD / 8);
        kr[i] = *(const GAS u32x4*)(Kg + (size_t)row * pitch + ch * 8); }
}
template <int KD> __device__ __forceinline__ void stage_write_k(LAS unsigned char* kb, const u32x4 (&kr)[KD / 64], int tid) {
#pragma unroll
    for (int i = 0; i < KD / 64; ++i) { const int p = tid + 512 * i, row = p / (KD / 8), ch = p % (KD / 8);
        *(LAS u32x4*)(kb + row * (KD * 2) + kswz<KD>(row, ch) * 16) = kr[i]; }
}
template <int DV> __device__ __forceinline__ void stage_load_v(u32x4 (&vr)[DV / 64], const u16* Vg, int pitch, int wave, int lane) {
#pragma unroll
    for (int i = 0; i < DV / 64; ++i) { const int p = wave + 8 * i, dh = p >> 2, rg = p & 3;
        vr[i] = *(const GAS u32x4*)(Vg + (size_t)(16 * rg + (lane >> 2)) * pitch + dh * 32 + (lane & 3) * 8); }
}
template <int DV> __device__ __forceinline__ void stage_write_v(LAS unsigned char* vb, const u32x4 (&vr)[DV / 64], int wave, int lane) {
#pragma unroll
    for (int i = 0; i < DV / 64; ++i) *(LAS u32x4*)(vb + (wave + 8 * i) * 1024 + lane * 16) = vr[i];
}
template <int KD, int VAR = 0> __device__ __forceinline__ void qk_tile(f32x16& p0, f32x16& p1, const LAS unsigned char* kbuf, int chunk0, int r32, int hi, const half8 (&qr)[4], const f32x16& z) {
    const LAS unsigned char* kb = kbuf + r32 * (KD * 2);
    half8 b0[4], b1[4];
#pragma unroll
    for (int d0 = 0; d0 < 4; ++d0) {
        const int off = kswz<KD>(r32, chunk0 + 2 * d0 + hi) * 16;
        b0[d0] = *(const LAS half8*)(kb + off); b1[d0] = *(const LAS half8*)(kb + 32 * (KD * 2) + off);
    }
    __builtin_amdgcn_sched_barrier(0);
    if (VAR == 3) { p0 = z; p1 = z; p0[0] = (float)b0[0][0] + (float)b1[1][0] + (float)b0[2][0] + (float)b1[3][0]; p1[0] = (float)b1[0][0] + (float)b0[1][0] + (float)b1[2][0] + (float)b0[3][0]; return; }
#pragma unroll
    for (int d0 = 0; d0 < 4; ++d0) {
        p0 = __builtin_amdgcn_mfma_f32_32x32x16_f16(b0[d0], qr[d0], d0 ? p0 : z, 0, 0, 0);
        p1 = __builtin_amdgcn_mfma_f32_32x32x16_f16(b1[d0], qr[d0], d0 ? p1 : z, 0, 0, 0);
    }
}
__device__ __forceinline__ float swap_max(float m) { auto rr = __builtin_amdgcn_permlane32_swap(__float_as_uint(m), __float_as_uint(m), false, false); return fmaxf(__uint_as_float(rr[0]), __uint_as_float(rr[1])); }
__device__ __forceinline__ float swap_sum(float m) { auto rr = __builtin_amdgcn_permlane32_swap(__float_as_uint(m), __float_as_uint(m), false, false); return __uint_as_float(rr[0]) + __uint_as_float(rr[1]); }
__device__ __forceinline__ float max3f(float a, float b, float c) { float r; asm("v_max3_f32 %0, %1, %2, %3" : "=v"(r) : "v"(a), "v"(b), "v"(c)); return r; }
typedef float f32x2 __attribute__((ext_vector_type(2)));
template <int DV> __device__ __forceinline__ void softmax_tile(f32x16& p0, f32x16& p1, float& m, int& started, f32x16& negm, float& l, f32x16 (&o)[DV / 32], LAS float* wsf, int r32, int hi, u32x4 (&pw)[4]) {
    asm volatile("s_nop 7\n\ts_nop 7\n\ts_nop 7" : "+v"(p0), "+v"(p1));
    float a = max3f(p0[0], p0[1], p1[0]), b = max3f(p0[2], p0[3], p1[1]); a = max3f(a, p1[2], p1[3]);
#pragma unroll
    for (int r = 4; r < 16; r += 4) { a = max3f(a, p0[r], p0[r + 1]); b = max3f(b, p0[r + 2], p0[r + 3]); a = max3f(a, p1[r], p1[r + 1]); b = max3f(b, p1[r + 2], p1[r + 3]); }
    const float rm = swap_max(max3f(a, b, b));
    const bool first = (started == 0) && (rm > -INFINITY);
    if (__any(first || rm > 8.0f)) {
        float delta = 0.f, f = 1.f;
        if (first) { delta = rm; started = 1; }
        else if (started && rm > 8.0f) { delta = rm; f = __builtin_amdgcn_exp2f(-rm); }
        m += delta; l *= f;
#pragma unroll
        for (int r = 0; r < 16; ++r) { p0[r] -= delta; p1[r] -= delta; negm[r] = -m; }
        if (hi == 0) wsf[r32] = f;
        asm volatile("s_waitcnt lgkmcnt(0)" ::: "memory");
#pragma unroll
        for (int r = 0; r < 16; ++r) { const float fr_ = wsf[crow(r, hi)];
#pragma unroll
            for (int d0 = 0; d0 < DV / 32; ++d0) o[d0][r] *= fr_; }
    }
    f32x2 s2 = {0.f, 0.f};
#pragma unroll
    for (int r = 0; r < 16; r += 2) {
        p0[r] = __builtin_amdgcn_exp2f(p0[r]); p0[r + 1] = __builtin_amdgcn_exp2f(p0[r + 1]); p1[r] = __builtin_amdgcn_exp2f(p1[r]); p1[r + 1] = __builtin_amdgcn_exp2f(p1[r + 1]);
        s2 += (f32x2){p0[r], p0[r + 1]}; s2 += (f32x2){p1[r], p1[r + 1]};
    }
    l += s2.x + s2.y;
    pw[0] = (u32x4){pkh(p0[0], p0[1]), pkh(p0[2], p0[3]), pkh(p0[4], p0[5]), pkh(p0[6], p0[7])};
    pw[1] = (u32x4){pkh(p0[8], p0[9]), pkh(p0[10], p0[11]), pkh(p0[12], p0[13]), pkh(p0[14], p0[15])};
    pw[2] = (u32x4){pkh(p1[0], p1[1]), pkh(p1[2], p1[3]), pkh(p1[4], p1[5]), pkh(p1[6], p1[7])};
    pw[3] = (u32x4){pkh(p1[8], p1[9]), pkh(p1[10], p1[11]), pkh(p1[12], p1[13]), pkh(p1[14], p1[15])};
}
__device__ __forceinline__ v4i16 vtr(const LAS unsigned char* p) { return __builtin_amdgcn_ds_read_tr16_b64_v4i16((LAS v4i16*)p); }
struct VFrag { v4i16 lo[2][2], hh[2][2]; };
__device__ __forceinline__ void v_group_load(VFrag& f, const LAS unsigned char* vb, int g) {
    const int dp = g >> 1, kh = g & 1;
#pragma unroll
    for (int e = 0; e < 2; ++e)
#pragma unroll
        for (int k2 = 0; k2 < 2; ++k2) { const int ks = 2 * kh + k2; f.lo[e][k2] = vtr(vb + (2 * dp + e) * 4096 + ks * 1024); f.hh[e][k2] = vtr(vb + (2 * dp + e) * 4096 + ks * 1024 + 512); }
}
template <int DV> __device__ __forceinline__ void v_group_mma(f32x16 (&o)[DV / 32], const VFrag& f, const u32x4 (&pw)[4], int g) {
    const int dp = g >> 1, kh = g & 1;
#pragma unroll
    for (int k2 = 0; k2 < 2; ++k2)
#pragma unroll
        for (int e = 0; e < 2; ++e) {
            const s16x8 vf = {f.lo[e][k2][0], f.lo[e][k2][1], f.lo[e][k2][2], f.lo[e][k2][3], f.hh[e][k2][0], f.hh[e][k2][1], f.hh[e][k2][2], f.hh[e][k2][3]};
            o[2 * dp + e] = __builtin_amdgcn_mfma_f32_32x32x16_f16(__builtin_bit_cast(half8, pw[2 * kh + k2]), __builtin_bit_cast(half8, vf), o[2 * dp + e], 0, 0, 0);
        }
}
template <int DV> __device__ __forceinline__ void pv_tile(f32x16 (&o)[DV / 32], const LAS unsigned char* vb, const u32x4 (&pw)[4], VFrag& fA) {
    VFrag fB;
    v_group_load(fB, vb, 1); __builtin_amdgcn_sched_barrier(0);
    v_group_mma<DV>(o, fA, pw, 0); __builtin_amdgcn_sched_barrier(0);
    if (DV == 128) {
        v_group_load(fA, vb, 2); __builtin_amdgcn_sched_barrier(0);
        v_group_mma<DV>(o, fB, pw, 1); __builtin_amdgcn_sched_barrier(0);
        v_group_load(fB, vb, 3); __builtin_amdgcn_sched_barrier(0);
        v_group_mma<DV>(o, fA, pw, 2); __builtin_amdgcn_sched_barrier(0);
        v_group_mma<DV>(o, fB, pw, 3); __builtin_amdgcn_sched_barrier(0);
    } else {
        v_group_mma<DV>(o, fB, pw, 1); __builtin_amdgcn_sched_barrier(0);
    }
}
__device__ __forceinline__ int vtr_lane_off(int lane) { const int hi = lane >> 5; return ((lane >> 4) & 1) * 32 + (lane & 3) * 8 + (4 * hi + ((lane & 15) >> 2)) * 64; }
__device__ __forceinline__ void finalize_rows(float l, float gate, LAS float* wsf, int r32, int hi, float (&rli)[16]) {
    l = swap_sum(l);
    if (hi == 0) wsf[32 + r32] = gate / fmaxf(l, 1e-30f);
    asm volatile("s_waitcnt lgkmcnt(0)" ::: "memory");
#pragma unroll
    for (int r = 0; r < 16; ++r) rli[r] = wsf[32 + crow(r, hi)];
    asm volatile("s_waitcnt lgkmcnt(0)" ::: "memory");
}

template <int KD, int DV, int MODE, int VAR = 0>
__device__ __forceinline__ void attn_range_loop(const Frame& F, const u16* Kg, int kpitch, int kchunk0, const u16* Vg, int vpitch, u64 tiles, int kmax, int kmin, u64 rowsel, const LAS u64* ml,
                                                const half8 (&qr)[4], f32x16 (&o)[DV / 32], float& m, float& l) {
    const int lane = F.lane, wave = F.wave, r32 = lane & 31, hi = lane >> 5;
    LAS float* wsf = (LAS float*)(F.lds + WSCR_OFF + wave * 1024);
    m = 0.f; l = 0.f; int started = 0;
    f32x16 negm = {0.f, 0.f, 0.f, 0.f, 0.f, 0.f, 0.f, 0.f, 0.f, 0.f, 0.f, 0.f, 0.f, 0.f, 0.f, 0.f};
    if (tiles == 0ull) return;
    u32x4 krA[KD / 64], vrA[DV / 64], krB[KD / 64], vrB[DV / 64];
    int Tlast;
    { const int T0 = __builtin_ctzll(tiles); Tlast = 63 - __builtin_clzll(tiles);
      stage_load_k<KD>(krA, Kg + (size_t)T0 * 64 * kpitch, kpitch, F.tid); stage_load_v<DV>(vrA, Vg + (size_t)T0 * 64 * vpitch, vpitch, wave, lane);
      stage_write_k<KD>(F.lds + A_KB, krA, F.tid); stage_write_v<DV>(F.lds + A_VB, vrA, wave, lane);
      const u64 t1 = tiles & (tiles - 1ull);
      const int T1 = t1 ? __builtin_ctzll(t1) : Tlast;
      stage_load_k<KD>(krA, Kg + (size_t)T1 * 64 * kpitch, kpitch, F.tid); stage_load_v<DV>(vrA, Vg + (size_t)T1 * 64 * vpitch, vpitch, wave, lane); }
    __syncthreads();
    const int voff = vtr_lane_off(lane);
    int cur = 0;
#define ATTN_STEP(RNk, RNv, RFk, RFv) { \
        const int Tt = __builtin_ctzll(tiles); tiles &= tiles - 1ull; \
        const bool more = tiles != 0ull; \
        { const u64 t2 = tiles & (tiles - 1ull); \
          const int T2 = t2 ? __builtin_ctzll(t2) : Tlast; \
          stage_load_k<KD>(RFk, Kg + (size_t)T2 * 64 * kpitch, kpitch, F.tid); stage_load_v<DV>(RFv, Vg + (size_t)T2 * 64 * vpitch, vpitch, wave, lane); } \
        f32x16 p0, p1; u32x4 pw[4]; \
        qk_tile<KD>(p0, p1, F.lds + A_KB + cur * 16384, kchunk0, r32, hi, qr, negm); \
        VFrag vf0; if (DV == 64) v_group_load(vf0, F.lds + A_VB + cur * 16384 + voff, 0);     \
        if (VAR == 2) { } else if (MODE == 1) { const u64 mk = ml[Tt * 32 + r32]; const int mlo = (int)((unsigned)mk >> (4 * hi)), mhi = (int)((unsigned)(mk >> 32) >> (4 * hi)); \
            _Pragma("unroll") for (int r = 0; r < 16; ++r) {     \
                const unsigned s0 = (unsigned)__builtin_amdgcn_sbfe(mlo, crow(r, 0), 1), s1 = (unsigned)__builtin_amdgcn_sbfe(mhi, crow(r, 0), 1); \
                p0[r] = __uint_as_float((__float_as_uint(p0[r]) & s0) | (0xff800000u & ~s0)); p1[r] = __uint_as_float((__float_as_uint(p1[r]) & s1) | (0xff800000u & ~s1)); } } \
        else { const int eff = ((rowsel >> Tt) & 1ull) ? kmax : -1; const int kv0 = 64 * Tt + 4 * hi; \
            if (__any(64 * Tt + 63 > eff)) { const int dd = eff - kv0; \
                _Pragma("unroll") for (int r = 0; r < 16; ++r) { p0[r] = (dd >= crow(r, 0)) ? p0[r] : -INFINITY; p1[r] = (dd >= crow(r, 0) + 32) ? p1[r] : -INFINITY; } } \
            if (__any(64 * Tt < kmin)) { const int dd = kmin - kv0; \
                _Pragma("unroll") for (int r = 0; r < 16; ++r) { p0[r] = (crow(r, 0) >= dd) ? p0[r] : -INFINITY; p1[r] = (crow(r, 0) + 32 >= dd) ? p1[r] : -INFINITY; } } } \
        softmax_tile<DV>(p0, p1, m, started, negm, l, o, wsf, r32, hi, pw); \
        if (DV != 64) v_group_load(vf0, F.lds + A_VB + cur * 16384 + voff, 0); \
        pv_tile<DV>(o, F.lds + A_VB + cur * 16384 + voff, pw, vf0); \
        stage_write_k<KD>(F.lds + A_KB + (cur ^ 1) * 16384, RNk, F.tid); stage_write_v<DV>(F.lds + A_VB + (cur ^ 1) * 16384, RNv, wave, lane); \
        __syncthreads(); cur ^= 1; \
        if (!more) break; }
    for (;;) {
        ATTN_STEP(krA, vrA, krB, vrB)
        ATTN_STEP(krB, vrB, krA, vrA)
    }
#undef ATTN_STEP
}

__device__ __forceinline__ void hs_glds16(const void* gsrc, unsigned lds_dst) { unsigned keep;
    asm volatile("s_mov_b32 %0, m0\n\ts_mov_b32 m0, %2\n\ts_nop 0\n\tglobal_load_lds_dwordx4 %1, off\n\ts_mov_b32 m0, %0" : "=&s"(keep) : "v"(gsrc), "s"(lds_dst) : "memory"); }

template <int MODE>
__device__ __forceinline__ void attn_dma_loop(const Frame& F, const u16* Kg, int kpitch, const u16* Vg, int vpitch, u64 tiles, int kmax, int kmin, u64 rowsel, const LAS u64* ml,
                                              const half8 (&qr)[4], f32x16 (&o)[2], float& m, float& l) {
    const int lane = F.lane, wave = F.wave, r32 = lane & 31, hi = lane >> 5;
    LAS float* wsf = (LAS float*)(F.lds + WSCR_OFF + wave * 1024);
    m = 0.f; l = 0.f; int started = 0;
    f32x16 negm = {0.f, 0.f, 0.f, 0.f, 0.f, 0.f, 0.f, 0.f, 0.f, 0.f, 0.f, 0.f, 0.f, 0.f, 0.f, 0.f};
    if (tiles == 0ull) return;
    constexpr int SL = 8192, VB = 3 * SL;
    const int lds0 = (int)(unsigned)(size_t)F.lds;
    const int krow = 8 * wave + (lane >> 3), kch = (lane & 7) ^ ((krow >> 1) & 7);
    const unsigned kso = (unsigned)(krow * kpitch + kch * 8) * 2u;
    const unsigned vso = (unsigned)((16 * (wave & 3) + (lane >> 2)) * vpitch + (wave >> 2) * 32 + (lane & 3) * 8) * 2u;
#define AD_DMA(T_, slot_) { hs_glds16((const char*)Kg + (size_t)(T_) * 128 * kpitch + kso, (unsigned)__builtin_amdgcn_readfirstlane(lds0 + (slot_) + wave * 1024)); \
                            hs_glds16((const char*)Vg + (size_t)(T_) * 128 * vpitch + vso, (unsigned)__builtin_amdgcn_readfirstlane(lds0 + VB + (slot_) + wave * 1024)); }
    int Tlast;
    { const int T0 = __builtin_ctzll(tiles); Tlast = 63 - __builtin_clzll(tiles);
      AD_DMA(T0, 0)
      const u64 t1 = tiles & (tiles - 1ull);
      const int T1 = t1 ? __builtin_ctzll(t1) : Tlast;
      AD_DMA(T1, SL) }
    asm volatile("s_waitcnt vmcnt(2) lgkmcnt(0)\n\ts_barrier" ::: "memory");
    const int voff = vtr_lane_off(lane);
    int sc = 0, sn2 = 2 * SL;
    for (;;) {
        sc = __builtin_amdgcn_readfirstlane(sc); sn2 = __builtin_amdgcn_readfirstlane(sn2);
        const int Tt = __builtin_ctzll(tiles); tiles &= tiles - 1ull;
        const bool more = tiles != 0ull;
        { const u64 t2 = tiles & (tiles - 1ull);
          const int T2 = t2 ? __builtin_ctzll(t2) : Tlast;
          AD_DMA(T2, sn2) }
        bool active = true;
        if (MODE == 0) active = __any(((rowsel >> Tt) & 1ull) != 0ull && kmax >= 64 * Tt && kmin <= 64 * Tt + 63);
        if (active) {
        f32x16 p0, p1; u32x4 pw[4];
        qk_tile<64>(p0, p1, F.lds + sc, 0, r32, hi, qr, negm);
        VFrag vf0; v_group_load(vf0, F.lds + VB + sc + voff, 0);
        if (MODE == 1) { const u64 mk = ml[Tt * 32 + r32]; const int mlo = (int)((unsigned)mk >> (4 * hi)), mhi = (int)((unsigned)(mk >> 32) >> (4 * hi));
#pragma unroll
            for (int r = 0; r < 16; ++r) {
                const unsigned s0 = (unsigned)__builtin_amdgcn_sbfe(mlo, crow(r, 0), 1), s1 = (unsigned)__builtin_amdgcn_sbfe(mhi, crow(r, 0), 1);
                p0[r] = __uint_as_float((__float_as_uint(p0[r]) & s0) | (0xff800000u & ~s0)); p1[r] = __uint_as_float((__float_as_uint(p1[r]) & s1) | (0xff800000u & ~s1)); } }
        else { const int eff = ((rowsel >> Tt) & 1ull) ? kmax : -1; const int kv0 = 64 * Tt + 4 * hi;
            if (__any(64 * Tt + 63 > eff)) { const int dd = eff - kv0;
#pragma unroll
                for (int r = 0; r < 16; ++r) { p0[r] = (dd >= crow(r, 0)) ? p0[r] : -INFINITY; p1[r] = (dd >= crow(r, 0) + 32) ? p1[r] : -INFINITY; } }
            if (__any(64 * Tt < kmin)) { const int dd = kmin - kv0;
#pragma unroll
                for (int r = 0; r < 16; ++r) { p0[r] = (crow(r, 0) >= dd) ? p0[r] : -INFINITY; p1[r] = (crow(r, 0) + 32 >= dd) ? p1[r] : -INFINITY; } } }
        softmax_tile<64>(p0, p1, m, started, negm, l, o, wsf, r32, hi, pw);
        pv_tile<64>(o, F.lds + VB + sc + voff, pw, vf0);
        }
        asm volatile("s_waitcnt vmcnt(2) lgkmcnt(0)\n\ts_barrier" ::: "memory");
        sn2 = sc; sc = (sc == 2 * SL) ? 0 : sc + SL;
        if (!more) break;
    }
    asm volatile("s_waitcnt vmcnt(0)" ::: "memory");
    __syncthreads();
#undef AD_DMA
}

#define HS_SBAR() __builtin_amdgcn_sched_barrier(0)
#define HS_PIN(x) asm volatile("" : "+v"(x))
#define HS_WAIT_BAR(N) asm volatile("s_waitcnt vmcnt(" #N ") lgkmcnt(0)\n\ts_barrier" ::: "memory")
struct HsVf { v4i16 lo, hh; };
__device__ __forceinline__ void diff_loop_hs(const Frame& F, const u16* Kg, const u16* Vg, int NT, int tq, int chunk0, const half8 (&qr)[4], f32x16 (&o)[4], float& l_out) {
    const int lane = F.lane, wave = F.wave, r32 = lane & 31, hi = lane >> 5;
    LAS float* wsf = (LAS float*)(F.lds + WSCR_OFF + wave * 1024);
    constexpr int SLOT = 16384, VB = 3 * SLOT;
    constexpr size_t TSTEP = (size_t)64 * ODD_N * 2;
    unsigned kso[2], vso[2];
#pragma unroll
    for (int i = 0; i < 2; ++i) { const int p = wave + 8 * i, row = 4 * p + (lane >> 4), c = (lane & 15) ^ (row & 15); kso[i] = (unsigned)(row * ODD_N + c * 8) * 2u; }
#pragma unroll
    for (int i = 0; i < 2; ++i) { const int p = wave + 8 * i, dh = p >> 2, rg = p & 3; vso[i] = (unsigned)((16 * rg + (lane >> 2)) * ODD_N + dh * 32 + (lane & 3) * 8) * 2u; }
#define HS_DMA_K(t_, slot_) { const int tt_ = ((t_) < NT) ? (t_) : NT - 1; const char* g_ = (const char*)Kg + (size_t)tt_ * TSTEP; \
        _Pragma("unroll") for (int i_ = 0; i_ < 2; ++i_) hs_glds16(g_ + kso[i_], (unsigned)__builtin_amdgcn_readfirstlane(lds0 + (slot_) + (wave + 8 * i_) * 1024)); }
#define HS_DMA_V(t_, slot_) { const int tt_ = ((t_) < NT) ? (t_) : NT - 1; const char* g_ = (const char*)Vg + (size_t)tt_ * TSTEP; \
        _Pragma("unroll") for (int i_ = 0; i_ < 2; ++i_) hs_glds16(g_ + vso[i_], (unsigned)__builtin_amdgcn_readfirstlane(lds0 + VB + (slot_) + (wave + 8 * i_) * 1024)); }
    const int lds0 = (int)(unsigned)(size_t)F.lds;
    int kfo[4];
#pragma unroll
    for (int d0 = 0; d0 < 4; ++d0) kfo[d0] = r32 * 256 + (((chunk0 + 2 * d0 + hi) ^ (r32 & 15)) * 16);
    const int voff = vtr_lane_off(lane);
    HS_DMA_K(0, 0) HS_DMA_V(0, 0) HS_DMA_K(1, SLOT) HS_DMA_K(2, 2 * SLOT)
    f32x16 negm = {0.f, 0.f, 0.f, 0.f, 0.f, 0.f, 0.f, 0.f, 0.f, 0.f, 0.f, 0.f, 0.f, 0.f, 0.f, 0.f};
    f32x16 P[2]; half8 kf[8]; u32x4 pw[4]; HsVf vf[4];
    float m = 0.f, l = 0.f; bool resc = false;
#define HS_KLD(j_, slot_) kf[j_] = *(const LAS half8*)(F.lds + (slot_) + kfo[(j_) >> 1] + ((j_) & 1) * 8192)
#define HS_MASK(t_) { const int dd_ = tq - (64 * (t_) + 4 * hi); \
        _Pragma("unroll") for (int r = 0; r < 16; ++r) { P[0][r] = (dd_ >= crow(r, 0)) ? P[0][r] : -INFINITY; P[1][r] = (dd_ >= crow(r, 0) + 32) ? P[1][r] : -INFINITY; } }
#define HS_MX3(a, b, c) __builtin_fmaxf(__builtin_fmaxf((a), (b)), (c))
#define HS_ROWMAX(rm_) { float a_ = HS_MX3(P[0][0], P[0][1], P[1][0]), b_ = HS_MX3(P[0][2], P[0][3], P[1][1]); a_ = HS_MX3(a_, P[1][2], P[1][3]); \
        _Pragma("unroll") for (int r = 4; r < 16; r += 4) { a_ = HS_MX3(a_, P[0][r], P[0][r + 1]); b_ = HS_MX3(b_, P[0][r + 2], P[0][r + 3]); a_ = HS_MX3(a_, P[1][r], P[1][r + 1]); b_ = HS_MX3(b_, P[1][r + 2], P[1][r + 3]); } \
        rm_ = swap_max(__builtin_fmaxf(a_, b_)); }
#define HS_PE(e_) P[(e_) >> 4][(e_) & 15]
    HS_WAIT_BAR(6);
#pragma unroll
    for (int j = 0; j < 8; ++j) HS_KLD(j, 0);
#pragma unroll
    for (int d0 = 0; d0 < 4; ++d0) {
        P[0] = __builtin_amdgcn_mfma_f32_32x32x16_f16(kf[2 * d0], qr[d0], d0 ? P[0] : negm, 0, 0, 0);
        P[1] = __builtin_amdgcn_mfma_f32_32x32x16_f16(kf[2 * d0 + 1], qr[d0], d0 ? P[1] : negm, 0, 0, 0); }
    if (NT == 2) HS_MASK(0)
    { float rm; HS_ROWMAX(rm) m = rm;
#pragma unroll
      for (int r = 0; r < 16; ++r) { P[0][r] -= rm; P[1][r] -= rm; negm[r] = -m; }
      float sacc = 0.f;
#pragma unroll
      for (int e = 0; e < 32; ++e) { HS_PE(e) = __builtin_amdgcn_exp2f(HS_PE(e)); sacc += HS_PE(e); }
      l = sacc;
#pragma unroll
      for (int c = 0; c < 16; ++c) pw[c >> 2][c & 3] = pkh(HS_PE(2 * c), HS_PE(2 * c + 1)); }
    HS_WAIT_BAR(2);
    HS_DMA_K(3, 0) HS_DMA_V(1, SLOT)
#pragma unroll
    for (int j = 0; j < 8; ++j) HS_KLD(j, SLOT);
#pragma unroll
    for (int d0 = 0; d0 < 4; ++d0) {
        P[0] = __builtin_amdgcn_mfma_f32_32x32x16_f16(kf[2 * d0], qr[d0], d0 ? P[0] : negm, 0, 0, 0);
        P[1] = __builtin_amdgcn_mfma_f32_32x32x16_f16(kf[2 * d0 + 1], qr[d0], d0 ? P[1] : negm, 0, 0, 0); }
    HS_WAIT_BAR(4);
    int sp = 0, sc = SLOT, sn = 2 * SLOT;
    for (int t = 1; t < NT; ++t) {
        const bool last = (t == NT - 1);
        sp = __builtin_amdgcn_readfirstlane(sp); sc = __builtin_amdgcn_readfirstlane(sc); sn = __builtin_amdgcn_readfirstlane(sn);
        HS_SBAR();
        HS_DMA_K(t + 3, sc) HS_DMA_V(t + 1, sn)
        const LAS unsigned char* vb = F.lds + VB + sp + voff;
#pragma unroll
        for (int d0 = 0; d0 < 4; ++d0) { vf[d0].lo = vtr(vb + d0 * 4096); vf[d0].hh = vtr(vb + d0 * 4096 + 512); }
        HS_SBAR();
        if (t >= NT - 2) HS_MASK(t)
        { float rm; HS_ROWMAX(rm)
          resc = false;
          if (__builtin_expect(__any(rm > 8.0f), 0)) {
              const float dl = __builtin_fmaxf(rm, 0.f); m += dl;
#pragma unroll
              for (int r = 0; r < 16; ++r) { P[0][r] -= dl; P[1][r] -= dl; negm[r] = -m; }
              HS_PIN(negm);
              const float f = __builtin_amdgcn_exp2f(-dl); l *= f; if (hi == 0) wsf[r32] = f; resc = true; } }
        HS_SBAR();
        float sacc = 0.f;
#pragma unroll
        for (int g = 0; g < 16; ++g) {
            const int ks = g >> 2, d0 = g & 3;
            { const s16x8 vfr = {vf[d0].lo[0], vf[d0].lo[1], vf[d0].lo[2], vf[d0].lo[3], vf[d0].hh[0], vf[d0].hh[1], vf[d0].hh[2], vf[d0].hh[3]};
              o[d0] = __builtin_amdgcn_mfma_f32_32x32x16_f16(__builtin_bit_cast(half8, pw[ks]), __builtin_bit_cast(half8, vfr), o[d0], 0, 0, 0); }
            if (g + 4 < 16) { const int ks2 = (g + 4) >> 2; vf[d0].lo = vtr(vb + d0 * 4096 + ks2 * 1024); vf[d0].hh = vtr(vb + d0 * 4096 + ks2 * 1024 + 512); }
            if (!last && g >= 4 && g < 12) { const int q_ = g - 4; const int j = (q_ == 0) ? 0 : (q_ == 1) ? 2 : (q_ == 2) ? 1 : (q_ == 3) ? 4 : (q_ == 4) ? 3 : (q_ == 5) ? 6 : (q_ == 6) ? 5 : 7; HS_KLD(j, sn); }
            HS_PE(2 * g) = __builtin_amdgcn_exp2f(HS_PE(2 * g)); HS_PE(2 * g + 1) = __builtin_amdgcn_exp2f(HS_PE(2 * g + 1));
            if (g >= 1) { sacc += HS_PE(2 * g - 2); sacc += HS_PE(2 * g - 1); HS_PIN(sacc); }
            if (g >= 4) { const int c = g - 4; pw[c >> 2][c & 3] = pkh(HS_PE(2 * c), HS_PE(2 * c + 1)); HS_PIN(pw[c >> 2]); }
            HS_PIN(P[0]); HS_PIN(P[1]);
            HS_SBAR();
        }
        if (!last) {
            P[0] = __builtin_amdgcn_mfma_f32_32x32x16_f16(kf[0], qr[0], negm, 0, 0, 0);
            sacc += P[1][14]; sacc += P[1][15]; pw[3][0] = pkh(P[1][8], P[1][9]); pw[3][1] = pkh(P[1][10], P[1][11]); HS_PIN(sacc); HS_PIN(pw[3]); HS_SBAR();
            P[0] = __builtin_amdgcn_mfma_f32_32x32x16_f16(kf[2], qr[1], P[0], 0, 0, 0);
            pw[3][2] = pkh(P[1][12], P[1][13]); pw[3][3] = pkh(P[1][14], P[1][15]); HS_PIN(pw[3]); HS_SBAR();
            P[1] = __builtin_amdgcn_mfma_f32_32x32x16_f16(kf[1], qr[0], negm, 0, 0, 0); HS_SBAR();
            P[0] = __builtin_amdgcn_mfma_f32_32x32x16_f16(kf[4], qr[2], P[0], 0, 0, 0); HS_SBAR();
            P[1] = __builtin_amdgcn_mfma_f32_32x32x16_f16(kf[3], qr[1], P[1], 0, 0, 0); HS_SBAR();
            P[0] = __builtin_amdgcn_mfma_f32_32x32x16_f16(kf[6], qr[3], P[0], 0, 0, 0); HS_SBAR();
            P[1] = __builtin_amdgcn_mfma_f32_32x32x16_f16(kf[5], qr[2], P[1], 0, 0, 0); HS_SBAR();
            P[1] = __builtin_amdgcn_mfma_f32_32x32x16_f16(kf[7], qr[3], P[1], 0, 0, 0); HS_SBAR();
            l += sacc;
            HS_WAIT_BAR(4);
        } else {
            sacc += P[1][14]; sacc += P[1][15]; l += sacc;
            pw[3] = (u32x4){pkh(P[1][8], P[1][9]), pkh(P[1][10], P[1][11]), pkh(P[1][12], P[1][13]), pkh(P[1][14], P[1][15])};
            HS_WAIT_BAR(0);
        }
        if (resc) {
            asm volatile("s_waitcnt lgkmcnt(0)" ::: "memory");
#pragma unroll
            for (int r = 0; r < 16; ++r) { const float fr_ = wsf[crow(r, hi)];
#pragma unroll
                for (int d0 = 0; d0 < 4; ++d0) o[d0][r] *= fr_; } }
        { const int s_ = sp; sp = sc; sc = sn; sn = s_; }
    }
    { const LAS unsigned char* vb = F.lds + VB + sp + voff;
#pragma unroll
      for (int d0 = 0; d0 < 4; ++d0) { vf[d0].lo = vtr(vb + d0 * 4096); vf[d0].hh = vtr(vb + d0 * 4096 + 512); }
#pragma unroll
      for (int g = 0; g < 16; ++g) {
          const int ks = g >> 2, d0 = g & 3;
          { const s16x8 vfr = {vf[d0].lo[0], vf[d0].lo[1], vf[d0].lo[2], vf[d0].lo[3], vf[d0].hh[0], vf[d0].hh[1], vf[d0].hh[2], vf[d0].hh[3]};
            o[d0] = __builtin_amdgcn_mfma_f32_32x32x16_f16(__builtin_bit_cast(half8, pw[ks]), __builtin_bit_cast(half8, vfr), o[d0], 0, 0, 0); }
          if (g + 4 < 16) { const int ks2 = (g + 4) >> 2; vf[d0].lo = vtr(vb + d0 * 4096 + ks2 * 1024); vf[d0].hh = vtr(vb + d0 * 4096 + ks2 * 1024 + 512); }
          HS_SBAR(); } }
    l_out = l;
    asm volatile("s_waitcnt lgkmcnt(0)\n\ts_barrier" ::: "memory");
#undef HS_DMA_K
#undef HS_DMA_V
#undef HS_KLD
#undef HS_MASK
#undef HS_MX3
#undef HS_ROWMAX
#undef HS_PE
}

template <int DV> __device__ __forceinline__ void flush_stage(const LAS u16* stg, u16* Og, int lane) {
    asm volatile("s_waitcnt lgkmcnt(0)" ::: "memory");
    constexpr int CPR = DV / 8, RPI = 64 / CPR;
#pragma unroll
    for (int i = 0; i < 32 / RPI; ++i) { const int row = i * RPI + lane / CPR, ch = lane % CPR;
        const u32x4 v = *(const LAS u32x4*)(stg + row * DV + ch * 8);
        *(GAS u32x4*)(Og + (size_t)row * DM + ch * 8) = v;
        if (DV == 128 && (i & 1)) asm volatile("" ::: "memory"); }
}


#ifndef PROBE_VAR
#define PROBE_VAR -1
#endif
template <int VAR> __device__ __forceinline__ void dsa_probe_unit(const Frame& F, int b, int qb) {
    const int lane = F.lane, wave = F.wave, r32 = lane & 31, hi = lane >> 5;
    unsigned char* ws = F.ws;
    const u16* Pb = (const u16*)(ws + WS_P) + (size_t)b * T * EVEN_N;
    const u64* MASK = (const u64*)(ws + WS_MASK);
    u16* O = (u16*)(ws + 224 * MiB);
    const int t0 = qb * 32, NT = ((t0 + 31) >> 6) + 1;
    LAS u64* ml = (LAS u64*)(F.lds + A_AUX);
    LAS float* wsf = (LAS float*)(F.lds + WSCR_OFF + wave * 1024);
    for (int i = F.tid; i < NT * 32; i += 512) { const int q = i & 31, tl = i >> 5; ml[tl * 32 + q] = ((const GAS u64*)MASK)[(size_t)(b * T + t0 + q) * 64 + tl]; }
    half8 qr[4];
    { const u16* qp = Pb + (size_t)(t0 + r32) * EVEN_N + C_QA + wave * 64 + hi * 8;
#pragma unroll
      for (int d0 = 0; d0 < 4; ++d0) qr[d0] = *(const GAS half8*)(qp + d0 * 16); }
    f32x16 o[2]; float m = 0.f, l = 0.f;
#pragma unroll
    for (int d0 = 0; d0 < 2; ++d0)
#pragma unroll
        for (int r = 0; r < 16; ++r) o[d0][r] = 0.f;
    const u64 tiles = (NT >= 64) ? ~0ull : ((1ull << NT) - 1ull);
    attn_range_loop<64, 64, 1, VAR>(F, Pb + C_KA, EVEN_N, 0, Pb + C_VA, EVEN_N, tiles, 0, 0, ~0ull, ml, qr, o, m, l);
    __syncthreads();
    float rli[16]; finalize_rows(l, 1.0f, wsf, r32, hi, rli);
    LAS u16* stg = (LAS u16*)(F.lds + A_AUX + 32768 + wave * 4096);
#pragma unroll
    for (int r = 0; r < 16; ++r)
#pragma unroll
        for (int d0 = 0; d0 < 2; ++d0) stg[crow(r, hi) * 64 + d0 * 32 + r32] = (u16)(pkh(o[d0][r] * rli[r], 0.f) & 0xffffu);
    flush_stage<64>(stg, O + (size_t)(b * T + t0) * DM + wave * 64, lane);
    __syncthreads();
}

__device__ __forceinline__ void dsa_unit(const Frame& F, int b, int qb) {
    const int lane = F.lane, wave = F.wave, r32 = lane & 31, hi = lane >> 5;
    unsigned char* ws = F.ws;
    const u16* Pb = (const u16*)(ws + WS_P) + (size_t)b * T * EVEN_N;
    const u64* MASK = (const u64*)(ws + WS_MASK);
    u16* O = (u16*)(ws + WS_O16);
    const int t0 = qb * 32, NT = ((t0 + 31) >> 6) + 1;
    LAS u64* ml = (LAS u64*)(F.lds + A_AUX);
    LAS float* wsf = (LAS float*)(F.lds + WSCR_OFF + wave * 1024);
    for (int i = F.tid; i < NT * 32; i += 512) { const int q = i & 31, tl = i >> 5; ml[tl * 32 + q] = ((const GAS u64*)MASK)[(size_t)(b * T + t0 + q) * 64 + tl]; }
    half8 qr[4];
    { const u16* qp = Pb + (size_t)(t0 + r32) * EVEN_N + C_QA + wave * 64 + hi * 8;
#pragma unroll
      for (int d0 = 0; d0 < 4; ++d0) qr[d0] = *(const GAS half8*)(qp + d0 * 16); }
    f32x16 o[2]; float m = NEG_BIG, l = 0.f;
#pragma unroll
    for (int d0 = 0; d0 < 2; ++d0)
#pragma unroll
        for (int r = 0; r < 16; ++r) o[d0][r] = 0.f;
    const u64 tiles = (NT >= 64) ? ~0ull : ((1ull << NT) - 1ull);
    attn_dma_loop<1>(F, Pb + C_KA, EVEN_N, Pb + C_VA, EVEN_N, tiles, 0, 0, ~0ull, ml, qr, o, m, l);
    float rli[16]; finalize_rows(l, 1.0f, wsf, r32, hi, rli);
    LAS u16* stg = (LAS u16*)(F.lds + A_AUX + 32768 + wave * 4096);
#pragma unroll
    for (int r = 0; r < 16; ++r)
#pragma unroll
        for (int d0 = 0; d0 < 2; ++d0) stg[crow(r, hi) * 64 + d0 * 32 + r32] = (u16)(pkh(o[d0][r] * rli[r], 0.f) & 0xffffu);
    flush_stage<64>(stg, O + (size_t)(b * T + t0) * DM + wave * 64, lane);
}

__device__ __forceinline__ float sigmoidf_(float x) { return 1.0f / (1.0f + __expf(-x)); }
__device__ __forceinline__ u64 wave_or64(u64 v) {
    unsigned lo = (unsigned)v, hh = (unsigned)(v >> 32);
#pragma unroll
    for (int o = 1; o < 64; o <<= 1) { lo |= __shfl_xor(lo, o); hh |= __shfl_xor(hh, o); }
    return ((u64)hh << 32) | lo;
}

__device__ __forceinline__ void nsa_unit(const Frame& F, int b, int g, int qb) {
    const int lane = F.lane, wave = F.wave, r32 = lane & 31, hi = lane >> 5;
    const int j = wave & 3, qs = wave >> 2, hb = g * 4 + j;
    unsigned char* ws = F.ws;
    const u16* Pb = (const u16*)(ws + WS_P) + (size_t)b * T * EVEN_N;
    const u16* KVC = (const u16*)(ws + WS_KVC);
    u16* O = (u16*)(ws + WS_O16);
    const int t0 = qb * 64, tq = t0 + 32 * qs + r32, cur = qb;
    LAS float* wsf = (LAS float*)(F.lds + WSCR_OFF + wave * 1024);
    LAS unsigned* imp = (LAS unsigned*)(F.lds + A_AUX);
    LAS u64* selm = (LAS u64*)(F.lds + A_AUX + 16896);
    for (int i = F.tid; i < 64 * 65; i += 512) imp[i] = 0u;
    const GAS u16* prow = (const GAS u16*)Pb + (size_t)tq * EVEN_N;
    half8 qr[4];
#pragma unroll
    for (int d0 = 0; d0 < 4; ++d0) qr[d0] = *(const GAS half8*)(prow + C_QB + hb * 64 + hi * 8 + d0 * 16);
    const float g0 = sigmoidf_(h2f(prow[C_GB + hb * 3 + 0])), g1 = sigmoidf_(h2f(prow[C_GB + hb * 3 + 1])), g2 = sigmoidf_(h2f(prow[C_GB + hb * 3 + 2]));
    unsigned oacc[2][8]; f32x16 o[2]; float m, l, rli[16];
#pragma unroll
    for (int d0 = 0; d0 < 2; ++d0)
#pragma unroll
        for (int r = 0; r < 8; ++r) oacc[d0][r] = 0u;
    const u16* kc = KVC + (size_t)((0 * 4 + b) * 2 + g) * 256 * 256;
    const u16* vc = KVC + (size_t)((1 * 4 + b) * 2 + g) * 256 * 256;
    const int ncmp = (tq >= 31) ? ((tq - 31) >> 4) : -1;
    const int ntc = ((t0 + 32) >> 10) + 1;
    u64 mysel = ~0ull, uni = 0ull;
    for (int br = 0; br < 3; ++br) {
        const u16* Kg; const u16* Vg; int pitch, kmax, kmin; u64 tiles, rsel; float gate;
        if (br == 0) { Kg = kc; Vg = vc; pitch = 256; kmax = ncmp; kmin = -(1 << 30); tiles = (1ull << ntc) - 1ull; rsel = ~0ull; gate = g0; }
        else if (br == 1) { Kg = Pb + C_KS + g * 64; Vg = Pb + C_VS + g * 64; pitch = EVEN_N; kmax = tq; kmin = -(1 << 30); tiles = uni; rsel = mysel; gate = g1; }
        else { Kg = Pb + (g ? C_KW1 : C_KW0); Vg = Pb + C_VW + g * 64; pitch = EVEN_N; kmax = tq; kmin = tq - 511; rsel = ~0ull; gate = g2;
               const int tlo = (cur - 8 > 0) ? cur - 8 : 0; tiles = ((cur == 63) ? ~0ull : ((1ull << (cur + 1)) - 1ull)) & ~((1ull << tlo) - 1ull); }
#pragma unroll
        for (int d0 = 0; d0 < 2; ++d0)
#pragma unroll
            for (int r = 0; r < 16; ++r) o[d0][r] = 0.f;
        m = NEG_BIG; l = 0.f;
        attn_dma_loop<0>(F, Kg, pitch, Vg, pitch, tiles, kmax, kmin, rsel, (const LAS u64*)nullptr, qr, o, m, l);
        const float lc = swap_sum(l), invc = 1.0f / fmaxf(lc, 1e-30f), mc = m;
        finalize_rows(l, gate, wsf, r32, hi, rli);
#pragma unroll
        for (int d0 = 0; d0 < 2; ++d0)
#pragma unroll
            for (int r = 0; r < 16; r += 2) oacc[d0][r >> 1] = pkh(h2f(oacc[d0][r >> 1] & 0xffffu) + o[d0][r] * rli[r], h2f(oacc[d0][r >> 1] >> 16) + o[d0][r + 1] * rli[r + 1]);
        if (br == 0) {
            u32x4 kr[1];
            stage_load_k<64>(kr, kc, 256, F.tid); stage_write_k<64>(F.lds + A_KB, kr, F.tid);
            __syncthreads();
            int cb = 0; const int qi = 32 * qs + r32;
            f32x16 negmc;
#pragma unroll
            for (int r = 0; r < 16; ++r) negmc[r] = -mc;
            for (int tl = 0; tl < ntc; ++tl) {
                const bool more = tl + 1 < ntc;
                if (more) stage_load_k<64>(kr, kc + (size_t)(tl + 1) * 64 * 256, 256, F.tid);
                f32x16 p0, p1;
                qk_tile<64>(p0, p1, F.lds + A_KB + cb * 16384, 0, r32, hi, qr, negmc);
                const int dd = ncmp - (64 * tl + 4 * hi);
#pragma unroll
                for (int r = 0; r < 16; ++r) {
                    p0[r] = (dd >= crow(r, 0)) ? __builtin_amdgcn_exp2f(p0[r]) * invc : 0.f;
                    p1[r] = (dd >= crow(r, 0) + 32) ? __builtin_amdgcn_exp2f(p1[r]) * invc : 0.f;
                }
#pragma unroll
                for (int i = 0; i < 4; ++i) {
                    { const float g4 = (p0[4 * i] + p0[4 * i + 1]) + (p0[4 * i + 2] + p0[4 * i + 3]); const int mi = tl * 16 + 2 * i + hi;
                      __hip_atomic_fetch_add(imp + qi * 65 + mi, (unsigned)(g4 * 67108864.0f + 0.5f), __ATOMIC_RELAXED, __HIP_MEMORY_SCOPE_WORKGROUP);
                      if (mi + 1 < 64) __hip_atomic_fetch_add(imp + qi * 65 + mi + 1, (unsigned)(p0[4 * i + 3] * 67108864.0f + 0.5f), __ATOMIC_RELAXED, __HIP_MEMORY_SCOPE_WORKGROUP); }
                    { const float g4 = (p1[4 * i] + p1[4 * i + 1]) + (p1[4 * i + 2] + p1[4 * i + 3]); const int mi = tl * 16 + 8 + 2 * i + hi;
                      __hip_atomic_fetch_add(imp + qi * 65 + mi, (unsigned)(g4 * 67108864.0f + 0.5f), __ATOMIC_RELAXED, __HIP_MEMORY_SCOPE_WORKGROUP);
                      if (mi + 1 < 64) __hip_atomic_fetch_add(imp + qi * 65 + mi + 1, (unsigned)(p1[4 * i + 3] * 67108864.0f + 0.5f), __ATOMIC_RELAXED, __HIP_MEMORY_SCOPE_WORKGROUP); }
                }
                if (more) stage_write_k<64>(F.lds + A_KB + (cb ^ 1) * 16384, kr, F.tid);
                __syncthreads(); cb ^= 1;
            }
            for (int qq = 0; qq < 8; ++qq) {
                const int q = wave * 8 + qq;
                unsigned key = imp[q * 65 + lane];
                if (lane == 0 || lane == cur || lane == cur - 1) key = 0x7fffffffu;
                const bool adm = lane <= cur;
                u64 mk;
                if (cur < 16) mk = __ballot(adm);
                else {
                    unsigned thr = 0u;
                    for (int bit = 30; bit >= 0; --bit) { const unsigned cand = thr | (1u << bit); if (__popcll(__ballot(adm && key >= cand)) >= 16) thr = cand; }
                    const u64 gt = __ballot(adm && key > thr);
                    u64 eq = __ballot(adm && key == thr);
                    int need = 16 - __popcll(gt), c = __popcll(eq);
                    while (c > need) { eq &= ~(1ull << (63 - __clzll(eq))); --c; }
                    mk = gt | eq;
                }
                if (lane == 0) selm[q] = mk;
            }
            __syncthreads();
            mysel = selm[32 * qs + r32];
            uni = wave_or64(selm[lane]);
        }
    }
    GAS u16* Ob = (GAS u16*)O + (size_t)(b * T + t0 + 32 * qs) * DM + 512 + hb * 64 + r32;
#pragma unroll
    for (int r = 0; r < 16; ++r)
#pragma unroll
        for (int d0 = 0; d0 < 2; ++d0) Ob[(size_t)crow(r, hi) * DM + d0 * 32] = (u16)((oacc[d0][r >> 1] >> (16 * (r & 1))) & 0xffffu);
    __syncthreads();
}

__device__ __forceinline__ void diff_unit(const Frame& F, int b, int h, int qb, float lam_val, float oml, const float* sg) {
    int lane = F.lane; asm volatile("" : "+v"(lane));
    const int wave = F.wave, r32 = lane & 31, hi = lane >> 5;
    const int c = wave >> 2, qs = wave & 3;
    unsigned char* ws = F.ws;
    const u16* Pb = (const u16*)(ws + WS_P) + (size_t)b * T * ODD_N;
    u16* O = (u16*)(ws + WS_O16);
    const int t0 = qb * 128, tq = t0 + 32 * qs + r32;
    LAS float* wsf = (LAS float*)(F.lds + WSCR_OFF + wave * 1024);
    half8 qr[4];
#pragma unroll
    for (int d0 = 0; d0 < 4; ++d0) qr[d0] = *(const GAS half8*)(Pb + (size_t)tq * ODD_N + (2 * h + c) * 64 + hi * 8 + d0 * 16);
    f32x16 o[4]; float m = NEG_BIG, l = 0.f, rli[16];
#pragma unroll
    for (int d0 = 0; d0 < 4; ++d0)
#pragma unroll
        for (int r = 0; r < 16; ++r) o[d0][r] = 0.f;
    const int NT = 2 * (qb + 1);
    const u64 tiles = (NT >= 64) ? ~0ull : ((1ull << NT) - 1ull);
    diff_loop_hs(F, Pb + 1024 + 2 * h * 64, Pb + 2048 + h * 128, NT, tq, 8 * c, qr, o, l); (void)m;
    finalize_rows(l, 1.0f, wsf, r32, hi, rli);
    LAS float* stg = (LAS float*)(F.lds) + (size_t)qs * 32 * 128;
    if (c == 1) {
#pragma unroll
        for (int r = 0; r < 16; ++r)
#pragma unroll
            for (int d0 = 0; d0 < 4; ++d0) stg[crow(r, hi) * 128 + d0 * 32 + r32] = o[d0][r] * rli[r];
    }
    __syncthreads();
    if (c == 0) {
        LAS float* ssb = (LAS float*)(F.lds + 65536 + qs * 16384);
        LAS u16* ost = (LAS u16*)(F.lds + 65536 + qs * 16384 + 8192);
#pragma unroll
        for (int r = 0; r < 16; ++r) {
            float ss = 0.f;
#pragma unroll
            for (int d0 = 0; d0 < 4; ++d0) { o[d0][r] = o[d0][r] * rli[r] - lam_val * stg[crow(r, hi) * 128 + d0 * 32 + r32]; ss += o[d0][r] * o[d0][r]; }
            ssb[crow(r, hi) * 36 + r32] = ss;
        }
        asm volatile("s_waitcnt lgkmcnt(0)" ::: "memory");
        { const int row = lane >> 1, half = lane & 1;
          const LAS f32x4* sp_ = (const LAS f32x4*)(ssb + row * 36 + half * 16);
          const f32x4 a0 = sp_[0], a1 = sp_[1], a2 = sp_[2], a3 = sp_[3];
          float tot = ((a0.x + a0.y) + (a0.z + a0.w)) + ((a1.x + a1.y) + (a1.z + a1.w)) + ((a2.x + a2.y) + (a2.z + a2.w)) + ((a3.x + a3.y) + (a3.z + a3.w));
          tot += __shfl_xor(tot, 1);
          const float rs = 1.0f / sqrtf(tot * (1.0f / 128.0f) + 1e-6f);
          if (half == 0) wsf[64 + row] = rs; }
        asm volatile("s_waitcnt lgkmcnt(0)" ::: "memory");
        float sgv[4];
#pragma unroll
        for (int d0 = 0; d0 < 4; ++d0) sgv[d0] = ((const GAS float*)sg)[d0 * 32 + r32] * oml;
#pragma unroll
        for (int r = 0; r < 16; ++r) { const float rs = wsf[64 + crow(r, hi)];
#pragma unroll
            for (int d0 = 0; d0 < 4; ++d0) ost[crow(r, hi) * 128 + d0 * 32 + r32] = (u16)(pkh(o[d0][r] * rs * sgv[d0], 0.f) & 0xffffu); }
        flush_stage<128>(ost, O + (size_t)(b * T + t0 + 32 * qs) * DM + h * 128, lane);
    }
    __syncthreads();
}

__device__ __forceinline__ void even_attn_phase(const Frame& F, int layer) {
    unsigned char* ws = F.ws;
    const u16* P = (const u16*)(ws + WS_P); u16* O = (u16*)(ws + WS_O16);
    const u64* MASK = (const u64*)(ws + WS_MASK);
    const u16* KVC = (const u16*)(ws + WS_KVC);
    const int gw = F.bid * 8 + F.wave, NGW = F.G * 8, lane = F.lane;
    LAS float* pbuf = (LAS float*)(F.lds + F.wave * 16384);
    if (F.G == 256) {
        const int xcd = F.bid & 7, jx = F.bid >> 3, b = xcd >> 1, i = (xcd & 1) * 32 + jx;
        for (int k = 0; k < 2; ++k) dsa_unit(F, b, k ? 127 - i : i);
#if PROBE_VAR >= 0
        __syncthreads();
        if (layer == 0) { for (int k = 0; k < 2; ++k) dsa_probe_unit<PROBE_VAR>(F, b, k ? 127 - i : i); }
#endif
    }
    __syncthreads();
    if (F.G == 256) {
        const int b = (F.bid & 7) >> 1, g = F.bid & 1, i = F.bid >> 3;
#ifndef NO_NSA
        for (int k = 0; k < 2; ++k) nsa_unit(F, b, g, k ? 63 - i : i);
#endif
    }
}

__device__ __forceinline__ void odd_attn_phase(const Frame& F, int layer) {
    const ArgsP ap = F.a; unsigned char* ws = F.ws; const int oi = layer >> 1;
    const u16* P = (const u16*)(ws + WS_P); u16* O = (u16*)(ws + WS_O16);
    const int gw = F.bid * 8 + F.wave, NGW = F.G * 8, lane = F.lane;
    LAS float* pbuf = (LAS float*)(F.lds + F.wave * 16384);
    const float* lam = G(ap->odd_lambda) + (size_t)oi * 4 * 64;
    const float l01 = wave_sum(lam[lane] * lam[64 + lane]), l23 = wave_sum(lam[128 + lane] * lam[192 + lane]);
    const float lambda_init = 0.8f - 0.6f * expf(-0.3f * (float)layer);
    const float lam_val = expf(l01) - expf(l23) + lambda_init;
    const float* sg = G(ap->odd_subln) + (size_t)oi * 128;
    if (F.G == 256) {
        const int bh = (F.bid & 7) * 4 + ((F.bid >> 3) >> 3), s8 = (F.bid >> 3) & 7;
#ifndef NO_DIFF
        for (int k = 0; k < 4; ++k) diff_unit(F, bh >> 3, bh & 7, (k == 0) ? s8 : (k == 1) ? 15 - s8 : (k == 2) ? 16 + s8 : 31 - s8, lam_val, 1.0f - lambda_init, sg);
#endif
    }
}

__device__ __forceinline__ void final_phase(const Frame& F) {
    const ArgsP ap = F.a; const float* psum = (const float*)(F.ws + WS_PSUM);
    const int gw = F.bid * 8 + F.wave, NGW = F.G * 8;
    for (int row = gw; row < M; row += NGW) {
        const float rs = pg8::rowscale(psum, row);
        f32x4* orow = (f32x4*)(G(ap->out) + (size_t)row * DM) + F.lane;
        const f32x4* gg = (const f32x4*)G(ap->final_g) + F.lane;
#pragma unroll
        for (int j = 0; j < 4; ++j) { f32x4 v = orow[64 * j]; const f32x4 g = gg[64 * j]; v = v * rs * g; orow[64 * j] = v; }
    }
}

__global__ void __launch_bounds__(512, 2) trunk_fwd(Args args) {
    extern __shared__ __attribute__((aligned(16))) unsigned char lds_raw[];
    Frame F;
    F.lds = (LAS unsigned char*)lds_raw; F.tid = threadIdx.x; F.lane = F.tid & 63; F.wave = __builtin_amdgcn_readfirstlane(F.tid >> 6);
    F.G = gridDim.x; F.bid = blockIdx.x; F.a = kargs(); F.ws = G(F.a->ws);
    unsigned char* ws = F.ws;
    const int ph_lo = F.a->ph_lo, ph_hi = F.a->ph_hi;
    for (int u = F.tid; u < (LDS_BYTES - LDSCTL_OFF) / 4; u += 512) ((LAS unsigned*)(F.lds + LDSCTL_OFF))[u] = 0u;
    __syncthreads();
    const bool multi = (ph_hi - ph_lo) > 1;
    const int wave_s = F.wave;
    XcdBarrier bar; bar.bar = (unsigned*)(ws + WS_CTL) + CW_BAR; bar.x = 0; bar.st = nullptr;
    if (multi) bar = xcd_barrier_post((unsigned*)(ws + WS_CTL) + CW_BAR, (volatile LAS unsigned*)(F.lds + MISC_OFF));

    const float* psum = nullptr;
#ifndef DUP_KIND
#define DUP_KIND -1
#endif
#ifndef DUP_PAR
#define DUP_PAR -1
#endif
    int dup_done = 0;
    for (int ph = ph_lo; ph < ph_hi; ++ph) {
        int layer, kind; phase_decode(ph, layer, kind);
        if (DUP_KIND >= 0 && kind == DUP_KIND && (DUP_PAR < 0 || (layer & 1) == DUP_PAR) && !dup_done) { dup_done = 1; --ph; }
        else dup_done = 0;
        F.a = kargs();
        { unsigned char* w_ = F.a->ws; int g_ = gridDim.x, b_ = blockIdx.x; asm volatile("" : "+s"(w_), "+s"(g_), "+s"(b_)); w_ = G(w_); ws = w_; F.ws = w_; F.G = g_; F.bid = b_; psum = (const float*)(w_ + WS_PSUM); }
        { int w_ = wave_s, z_ = 0; asm volatile("" : "+s"(w_), "+v"(z_)); int tid_ = w_ * 64 + (int)__builtin_amdgcn_mbcnt_hi(~0u, __builtin_amdgcn_mbcnt_lo(~0u, (unsigned)z_)); asm volatile("" : "+v"(tid_));     F.tid = tid_; F.lane = tid_ & 63; F.wave = __builtin_amdgcn_readfirstlane(tid_ >> 6); }
        const bool odd = (layer & 1) != 0;
#ifndef NO_PREP
        if (kind == K_PREP) prep_phase(F, layer); else
#endif
        if (0) {}
#ifndef NO_INPROJ
        else if (kind == K_INPROJ) {
            const int N = odd ? ODD_N : EVEN_N, NG = odd ? ODD_N : 2048;
            pg8::Gemm g{(const u16*)(ws + WS_X16), (const u16*)(ws + WS_WIN), M, NG, DM};
            pg8::StaticOrder S; S.init(M, NG, F.G, F.bid);
            const u64 rope_even = 0xFFull | (1ull << 8) | (0xFull << 10) | (1ull << 14) | (0xFFull << 15) | (3ull << 23) | (3ull << 27) | (1ull << 32) | (1ull << 35);
            const u64 scale_even = 0xFFull | (0xFFull << 15);
            const u64 rope_odd = 0xFFFFFFFFull, scale_odd = 0xFFFFull;
            pg8::EpiProj E{(u16*)(ws + WS_P), N, psum, (const float*)(ws + WS_COS), (const float*)(ws + WS_SIN), odd ? rope_odd : rope_even, odd ? scale_odd : scale_even, odd ? (u16*)nullptr : (u16*)(ws + WS_KIF)};
            pg8::gemm_phase<pg8::EpiProj, pg8::StaticOrder, true, true>(F.lds, F.tid, g, S, E);
        }
#endif
#ifndef NO_PRE
        else if (kind == K_PRE) pre_phase(F, layer);
#endif
#ifndef NO_CMP
        else if (kind == K_CMP1) {
            pg8::Gemm g{(const u16*)(ws + WS_AC), (const u16*)(ws + WS_WC1), 4096, 512, 2048};
            int one_ = 1; asm volatile("" : "+s"(one_)); pg8::DiagOrder S{F.bid, one_}; pg8::EpiCmp<1> E{(u16*)(ws + WS_HC)};
            pg8::gemm_phase<pg8::EpiCmp<1>, pg8::DiagOrder, true, true>(F.lds, F.tid, g, S, E);
            pg8::Gemm g2{(const u16*)(ws + WS_X16), (const u16*)(ws + WS_WIN), M, EVEN_N, DM};
            pg8::TailOrder S2{F.bid, one_};
            const u64 rope_even = 0xFFull | (1ull << 8) | (0xFull << 10) | (1ull << 14) | (0xFFull << 15) | (3ull << 23) | (3ull << 27) | (1ull << 32) | (1ull << 35);
            pg8::EpiProj E2{(u16*)(ws + WS_P), EVEN_N, psum, (const float*)(ws + WS_COS), (const float*)(ws + WS_SIN), rope_even, 0xFFull | (0xFFull << 15), (u16*)nullptr};
            pg8::gemm_phase<pg8::EpiProj, pg8::TailOrder, true, true>(F.lds, F.tid, g2, S2, E2);
            if (F.bid < 16) {
                asm volatile("s_waitcnt vmcnt(0)" ::: "memory"); __syncthreads();
                int k256_ = 256; asm volatile("" : "+s"(k256_));
                pg8::Gemm g3{(const u16*)(ws + WS_HC), (const u16*)(ws + WS_WC2), 4096, 512, k256_};
                pg8::DiagOrder S3{F.bid, one_}; pg8::EpiCmp<0> E3{(u16*)(ws + WS_KVC)};
                pg8::gemm_phase<pg8::EpiCmp<0>, pg8::DiagOrder, true, true>(F.lds, F.tid, g3, S3, E3);
            }
        }
#endif
#ifndef NO_ATTN
        else if (kind == K_ATTN) { if (odd) odd_attn_phase(F, layer); else even_attn_phase(F, layer); }
#endif
#ifndef NO_OUT
        else if (kind == K_OUTPROJ) {
            pg8::Gemm g{(const u16*)(ws + WS_O16), (const u16*)(ws + WS_WOUT), M, DM, DM};
            pg8::StaticOrder S; S.init(M, DM, F.G, F.bid);
            pg8::EpiResid E{layer == 0 ? G(F.a->x) : (const float*)G(F.a->out), G(F.a->out), (u16*)(ws + WS_X16), (float*)(ws + WS_PSUM)};
            pg8::gemm_phase<pg8::EpiResid, pg8::StaticOrder, true, true>(F.lds, F.tid, g, S, E);
        }
#endif
#ifndef NO_UP
        else if (kind == K_UP) {
            pg8::Gemm g{(const u16*)(ws + WS_X16), (const u16*)(ws + WS_WUP), M, DFF, DM};
            pg8::StaticOrder S; S.init(M, DFF, F.G, F.bid);
            pg8::EpiUp E{(u16*)(ws + WS_U), DFF, psum};
            pg8::gemm_phase<pg8::EpiUp, pg8::StaticOrder, true, true>(F.lds, F.tid, g, S, E);
        }
#endif
#ifndef NO_DOWN
        else if (kind == K_DOWN) {
            pg8::Gemm g{(const u16*)(ws + WS_U), (const u16*)(ws + WS_WDN), M, DM, DFF};
            pg8::StaticOrder S; S.init(M, DM, F.G, F.bid);
            pg8::EpiResid E{(const float*)G(F.a->out), G(F.a->out), (u16*)(ws + WS_X16), (float*)(ws + WS_PSUM)};
            pg8::gemm_phase<pg8::EpiResid, pg8::StaticOrder, true, true>(F.lds, F.tid, g, S, E);
        }
#endif
        else final_phase(F);
        if (ph + 1 < ph_hi || dup_done) xcd_barrier(bar);
    }
}

extern "C" void kernel_launch(void* const* d_in, const int* in_sizes, int n_in, void* d_out, int out_size, void* d_ws, size_t ws_size, hipStream_t stream) {
    static int grid = 0;
    if (grid == 0) {
        if (n_in != 15 || out_size != M * DM || ws_size < WS_END) { fprintf(stderr, "kernel_launch: unexpected shapes (n_in %d out %d ws %zu)\n", n_in, out_size, ws_size); grid = -1; return; }
        int dev = 0, cus = 0;
        if (hipGetDevice(&dev) != hipSuccess || hipDeviceGetAttribute(&cus, hipDeviceAttributeMultiprocessorCount, dev) != hipSuccess) { grid = -1; return; }
        if (hipFuncSetAttribute((const void*)trunk_fwd, hipFuncAttributeMaxDynamicSharedMemorySize, LDS_BYTES) != hipSuccess) { fprintf(stderr, "kernel_launch: hipFuncSetAttribute failed\n"); grid = -1; return; }
        int per_cu = 0;
        if (hipOccupancyMaxActiveBlocksPerMultiprocessor(&per_cu, (const void*)trunk_fwd, 512, LDS_BYTES) != hipSuccess || per_cu < 1) { fprintf(stderr, "kernel_launch: occupancy query says %d\n", per_cu); }
        (void)hipGetLastError();
        grid = cus;
    }
    if (grid < 0) return;
    (void)hipMemsetAsync((char*)d_ws + WS_CTL, 0, CTL_ZERO_BYTES, stream);
    Args a{};
    a.x = (const float*)d_in[0]; a.mix_g = (const float*)d_in[1]; a.mlp_g = (const float*)d_in[2]; a.even_w_in = (const float*)d_in[3]; a.even_pe = (const float*)d_in[4];
    a.even_w1 = (const float*)d_in[5]; a.even_w2 = (const float*)d_in[6]; a.even_w_out = (const float*)d_in[7]; a.odd_w_in = (const float*)d_in[8]; a.odd_lambda = (const float*)d_in[9];
    a.odd_subln = (const float*)d_in[10]; a.odd_w_out = (const float*)d_in[11]; a.mlp_up = (const float*)d_in[12]; a.mlp_down = (const float*)d_in[13]; a.final_g = (const float*)d_in[14];
    a.out = (float*)d_out; a.ws = (unsigned char*)d_ws;
#if MK_ONE_LAUNCH
    a.ph_lo = 0; a.ph_hi = NPHASE;
    hipLaunchKernelGGL(trunk_fwd, dim3(grid), dim3(512), LDS_BYTES, stream, a);
#else
    for (int ph = 0; ph < NPHASE; ++ph) { a.ph_lo = ph; a.ph_hi = ph + 1; hipLaunchKernelGGL(trunk_fwd, dim3(grid), dim3(512), LDS_BYTES, stream, a); }
#endif
}
```

```cpp
#include <hip/hip_runtime.h>
#include <cstdio>
#include <cstdint>

#ifndef MK_ONE_LAUNCH
#define MK_ONE_LAUNCH 1
#endif

#define LAS __attribute__((address_space(3)))
#define GAS __attribute__((address_space(1)))
typedef unsigned short u16;
typedef _Float16 half8 __attribute__((ext_vector_type(8)));
typedef _Float16 h16x2 __attribute__((ext_vector_type(2)));
typedef short s16x8 __attribute__((ext_vector_type(8)));
typedef float f32x4 __attribute__((ext_vector_type(4)));
typedef unsigned u32x4 __attribute__((ext_vector_type(4)));
typedef unsigned u32x2 __attribute__((ext_vector_type(2)));
typedef unsigned long long u64;

constexpr int NB = 4, T = 4096, M = NB * T, DM = 1024, DFF = 4096;
constexpr int EVEN_N = 2304, ODD_N = 3072;
constexpr int C_QA = 0, C_KA = 512, C_VA = 576, C_QI = 640, C_KI = 896, C_QB = 960, C_KVB = 1472, C_WI = 1984, C_GB = 1988;
constexpr int C_KC = C_KVB, C_VC = C_KVB + 128, C_KS = C_KVB + 256, C_VS = C_KVB + 384;
constexpr int C_KW0 = 2240, C_KW1 = 2048, C_VW = 2112;
constexpr float QSCALE = 0.125f * 1.4426950408889634f;

__device__ const float ROPE_INV[32] = {
    1.000000000e+00f, 7.498942018e-01f, 5.623413324e-01f, 4.216965139e-01f, 3.162277639e-01f, 2.371373922e-01f, 1.778279394e-01f, 1.333521456e-01f,
    1.000000015e-01f, 7.498941571e-02f, 5.623412877e-02f, 4.216964915e-02f, 3.162277862e-02f, 2.371373586e-02f, 1.778279431e-02f, 1.333521493e-02f,
    9.999999776e-03f, 7.498942316e-03f, 5.623413250e-03f, 4.216964822e-03f, 3.162277862e-03f, 2.371373819e-03f, 1.778279431e-03f, 1.333521446e-03f,
    1.000000047e-03f, 7.498941850e-04f, 5.623413017e-04f, 4.216965463e-04f, 3.162277862e-04f, 2.371373848e-04f, 1.778279402e-04f, 1.333521504e-04f};

template <class Tp> __device__ __forceinline__ Tp* G(Tp* p) { return (Tp*)(GAS Tp*)p; }
__device__ __forceinline__ unsigned pkh(float a, float b) { auto v = __builtin_amdgcn_cvt_pkrtz(a, b); return __builtin_bit_cast(unsigned, v); }
__device__ __forceinline__ float h2f(unsigned x) { return (float)__builtin_bit_cast(_Float16, (u16)x); }
__device__ __forceinline__ float wave_sum(float v) {
#pragma unroll
    for (int o = 1; o < 64; o <<= 1) v += __shfl_xor(v, o);
    return v;
}
__device__ __forceinline__ float wave_max(float v) {
#pragma unroll
    for (int o = 1; o < 64; o <<= 1) v = fmaxf(v, __shfl_xor(v, o));
    return v;
}
__device__ __forceinline__ void unpack8(const u32x4 w, float* f) {
    f[0] = h2f(w.x & 0xffffu); f[1] = h2f(w.x >> 16); f[2] = h2f(w.y & 0xffffu); f[3] = h2f(w.y >> 16);
    f[4] = h2f(w.z & 0xffffu); f[5] = h2f(w.z >> 16); f[6] = h2f(w.w & 0xffffu); f[7] = h2f(w.w >> 16);
}

namespace pg8 {
constexpr int BM = 256, BK = 64, HALF = 128, HTB = HALF * BK * 2, STAGE_BYTES = 8 * HTB, NXCD = 8, WGM = 8;
__host__ __device__ __forceinline__ int lds_byte(int r, int c) { const int st = (r >> 4) * 2 + (c >> 5), rr = r & 15, cc = c & 31, ob = rr * 64 + cc * 2; return st * 1024 + (ob ^ (((ob >> 9) & 1) << 5)); }
__host__ __device__ __forceinline__ void stage_rc(int b, int& R, int& C) { const int st = b / 1024, sb = b % 1024, swz = sb ^ (((sb >> 9) & 1) << 5); R = (st >> 1) * 16 + swz / 64; C = (st & 1) * 32 + (swz % 64) / 2; }
__host__ __device__ __forceinline__ int perm32(int rho) { const int n = rho >> 4, i = rho & 15; return 8 * (i >> 2) + 4 * n + (i & 3); }

struct Unit { int pm, pn; };
struct Gemm { const u16* A; const u16* Bt; int M, N, K; };

struct StaticOrder {
    int nM, nN, nwg, G, c;
    __host__ __device__ void init(int M_, int N_, int G_, int c_) { nM = M_ / BM; nN = N_ / BM; nwg = nM * nN; G = G_; c = c_; }
    __host__ __device__ bool next(int i, Unit& u) const {
        const long L = (long)i * G + c; if (L >= nwg) return false;
        int wgid = (int)L; { const int q = nwg / NXCD, r = nwg % NXCD, xcd = wgid % NXCD, off = wgid / NXCD; wgid = (xcd < r ? xcd * (q + 1) : r * (q + 1) + (xcd - r) * q) + off; }
        const int nig = WGM * nN, gid = wgid / nig, fm = gid * WGM, gsz = (nM - fm) < WGM ? (nM - fm) : WGM;
        u.pm = fm + ((wgid % nig) % gsz); u.pn = (wgid % nig) / gsz; return true;
    }
};
struct DiagOrder {
    int c, n;
    __host__ __device__ bool next(int i, Unit& u) const { if (i >= n || c >= 16) return false; u.pm = c; u.pn = c >> 3; return true; }
};

struct TailOrder {
    int c, n;
    __host__ __device__ bool next(int i, Unit& u) const { if (i >= n || c < 16 || c >= 80) return false; u.pm = c - 16; u.pn = 8; return true; }
};

__device__ __forceinline__ float rowscale(const float* psum, int row) {
    const GAS f32x4* p = (const GAS f32x4*)(psum + (size_t)row * 16);
    const f32x4 a = p[0], b = p[1], c = p[2], d = p[3];
    const float s = (((a.x + a.y) + (a.z + a.w)) + ((b.x + b.y) + (b.z + b.w))) + (((c.x + c.y) + (c.z + c.w)) + ((d.x + d.y) + (d.z + d.w)));
    return 1.0f / sqrtf(s * (1.0f / 1024.0f) + 1e-6f);
}

__device__ __forceinline__ void rowscales8(const float* psum, int rowbase  , int fq, float (&rs)[2][4]) {
    f32x4 ps[2][4];
#pragma unroll
    for (int ai = 0; ai < 2; ++ai)
#pragma unroll
        for (int m = 0; m < 4; ++m) ps[ai][m] = *(const GAS f32x4*)(psum + (size_t)(rowbase + ai * HALF + m * 16) * 16 + 4 * fq);
#pragma unroll
    for (int ai = 0; ai < 2; ++ai)
#pragma unroll
        for (int m = 0; m < 4; ++m) { float t = (ps[ai][m].x + ps[ai][m].y) + (ps[ai][m].z + ps[ai][m].w); t += __shfl_xor(t, 16); t += __shfl_xor(t, 32);
            rs[ai][m] = 1.0f / sqrtf(t * (1.0f / 1024.0f) + 1e-6f); }
}
struct EpiProj {
    static constexpr bool PERM = true, AFTER_DRAIN = false;
    u16* P; int ldp; const float* psum; const float* cosT; const float* sinT; u64 rope_mask, scale_mask; u16* kif;
    __device__ __forceinline__ void operator()(const f32x4 (&acc)[2][2][4][2], const Unit& u, int wr, int wc, int fr, int fq) const {
        const int d0 = 16 * (wc & 1) + 4 * fq, rowbase = u.pm * BM + wr * 64 + fr;
        float rs[2][4]; rowscales8(psum, rowbase, fq, rs);
        f32x4 cn, sn;
        { const int t = rowbase & (T - 1); cn = *(const GAS f32x4*)(cosT + t * 32 + d0); sn = *(const GAS f32x4*)(sinT + t * 32 + d0); }
#pragma unroll
        for (int ai = 0; ai < 2; ++ai)
#pragma unroll
            for (int m = 0; m < 4; ++m) {
                const int row = rowbase + ai * HALF + m * 16;
                const f32x4 c4 = cn, s4 = sn;
                if (ai * 4 + m < 7) { const int rn = rowbase + ((ai * 4 + m + 1) >> 2) * HALF + ((ai * 4 + m + 1) & 3) * 16, t = rn & (T - 1);
                    cn = *(const GAS f32x4*)(cosT + t * 32 + d0); sn = *(const GAS f32x4*)(sinT + t * 32 + d0); }
#pragma unroll
                for (int bj = 0; bj < 2; ++bj) {
                    const int head = u.pn * 4 + bj * 2 + (wc >> 1);
                    f32x4 v0 = acc[ai][bj][m][0] * rs[ai][m], v1 = acc[ai][bj][m][1] * rs[ai][m], o0 = v0, o1 = v1;
                    if ((rope_mask >> head) & 1ull) { o0 = v0 * c4 - v1 * s4; o1 = v1 * c4 + v0 * s4; }
                    if ((scale_mask >> head) & 1ull) { o0 = o0 * QSCALE; o1 = o1 * QSCALE; }
                    u16* dst = P + (size_t)row * ldp + head * 64 + d0;
                    u32x2 w0, w1; w0.x = pkh(o0[0], o0[1]); w0.y = pkh(o0[2], o0[3]); w1.x = pkh(o1[0], o1[1]); w1.y = pkh(o1[2], o1[3]);
                    { const auto rx = __builtin_amdgcn_permlane16_swap(w0.x, w1.x, false, false); const auto ry = __builtin_amdgcn_permlane16_swap(w0.y, w1.y, false, false);
                      const u32x4 w16 = {rx[0], ry[0], rx[1], ry[1]};
                      *(GAS u32x4*)(dst + ((fq & 1) ? 28 : 0)) = w16; }
                    if (kif != nullptr && head == 14) {
                        u16* kf = kif + ((size_t)(row >> 5) * 8 * 32 + (row & 31)) * 8;
                        const int dA = d0, dB = d0 + 32;
                        *(GAS u32x2*)(kf + (size_t)(((dA >> 4) * 2 + ((dA >> 3) & 1)) * 32) * 8 + (dA & 7)) = w0;
                        *(GAS u32x2*)(kf + (size_t)(((dB >> 4) * 2 + ((dB >> 3) & 1)) * 32) * 8 + (dB & 7)) = w1;
                    }
                }
            }
    }
};
struct EpiResid {
    static constexpr bool PERM = true, AFTER_DRAIN = false;
    const u16* hin; float* h; u16* x16; float* psum;
    __device__ __forceinline__ void operator()(const f32x4 (&acc)[2][2][4][2], const Unit& u, int wr, int wc, int fr, int fq) const {
        const int rowbase = u.pm * BM + wr * 64 + fr, colbase = u.pn * BM + wc * 32 + 8 * fq;
        u32x4 nx[2];
#pragma unroll
        for (int bj = 0; bj < 2; ++bj) nx[bj] = *(const GAS u32x4*)(hin + (size_t)rowbase * DM + colbase + bj * HALF);
#pragma unroll
        for (int ai = 0; ai < 2; ++ai)
#pragma unroll
            for (int m = 0; m < 4; ++m) {
                const int row = rowbase + ai * HALF + m * 16; float ss = 0.f;
                f32x4 cu[2][2];
#pragma unroll
                for (int bj = 0; bj < 2; ++bj) { const half8 hv = __builtin_bit_cast(half8, nx[bj]);
                    cu[bj][0] = (f32x4){(float)hv[0], (float)hv[1], (float)hv[2], (float)hv[3]}; cu[bj][1] = (f32x4){(float)hv[4], (float)hv[5], (float)hv[6], (float)hv[7]}; }
                if (ai * 4 + m < 7) { const int rn = rowbase + ((ai * 4 + m + 1) >> 2) * HALF + ((ai * 4 + m + 1) & 3) * 16;
#pragma unroll
                    for (int bj = 0; bj < 2; ++bj) nx[bj] = *(const GAS u32x4*)(hin + (size_t)rn * DM + colbase + bj * HALF); }
#pragma unroll
                for (int bj = 0; bj < 2; ++bj) {
                    const int col = colbase + bj * HALF;
                    float* hp = h + (size_t)row * DM + col;
                    const f32x4 a = cu[bj][0] + acc[ai][bj][m][0], b = cu[bj][1] + acc[ai][bj][m][1];
                    if (h != nullptr) { *(GAS f32x4*)hp = a; *(GAS f32x4*)(hp + 4) = b; }
                    ss += (a.x * a.x + a.y * a.y) + (a.z * a.z + a.w * a.w) + (b.x * b.x + b.y * b.y) + (b.z * b.z + b.w * b.w);
                    u32x4 w; w.x = pkh(a.x, a.y); w.y = pkh(a.z, a.w); w.z = pkh(b.x, b.y); w.w = pkh(b.z, b.w);
                    *(GAS u32x4*)(x16 + (size_t)row * DM + col) = w;
                }
                ss += __shfl_xor(ss, 16); ss += __shfl_xor(ss, 32);
                if (fq == 0) ((GAS float*)psum)[(size_t)row * 16 + u.pn * 4 + wc] = ss;
            }
    }
};
struct EpiUp {
    static constexpr bool PERM = true, AFTER_DRAIN = false;
    u16* U; int ldc; const float* psum;
    __device__ __forceinline__ void operator()(const f32x4 (&acc)[2][2][4][2], const Unit& u, int wr, int wc, int fr, int fq) const {
        const int rowbase = u.pm * BM + wr * 64 + fr;
        float rs[2][4]; rowscales8(psum, rowbase, fq, rs);
#pragma unroll
        for (int ai = 0; ai < 2; ++ai)
#pragma unroll
            for (int m = 0; m < 4; ++m) {
                const int row = rowbase + ai * HALF + m * 16;
#pragma unroll
                for (int bj = 0; bj < 2; ++bj) {
                    const int col = u.pn * BM + bj * HALF + wc * 32 + 8 * fq;
                    f32x4 a = acc[ai][bj][m][0] * rs[ai][m], b = acc[ai][bj][m][1] * rs[ai][m];
#pragma unroll
                    for (int i = 0; i < 4; ++i) { a[i] = fmaxf(a[i], 0.f); a[i] *= a[i]; b[i] = fmaxf(b[i], 0.f); b[i] *= b[i]; }
                    u32x4 w; w.x = pkh(a.x, a.y); w.y = pkh(a.z, a.w); w.z = pkh(b.x, b.y); w.w = pkh(b.z, b.w);
                    *(GAS u32x4*)(U + (size_t)row * ldc + col) = w;
                }
            }
    }
};
__device__ __forceinline__ float gelu_tanh(float x) {
    const float u = x * (1.5957691216057308f + 0.07135481627f * x * x);
    return x * __builtin_amdgcn_rcpf(1.0f + __builtin_amdgcn_exp2f(-1.4426950408889634f * u));
}
template <int ACT> struct EpiCmp {
    static constexpr bool PERM = true, AFTER_DRAIN = false;
    u16* O;
    __device__ __forceinline__ void operator()(const f32x4 (&acc)[2][2][4][2], const Unit& u, int wr, int wc, int fr, int fq) const {
#pragma unroll
        for (int ai = 0; ai < 2; ++ai)
#pragma unroll
            for (int m = 0; m < 4; ++m) {
                const int row = u.pm * BM + ai * HALF + wr * 64 + m * 16 + fr;
#pragma unroll
                for (int bj = 0; bj < 2; ++bj) {
                    const int col = bj * HALF + wc * 32 + 8 * fq;
                    f32x4 a = acc[ai][bj][m][0], b = acc[ai][bj][m][1];
                    if (ACT == 1) {
#pragma unroll
                        for (int i = 0; i < 4; ++i) { a[i] = gelu_tanh(a[i]); b[i] = gelu_tanh(b[i]); }
                    }
                    u32x4 w; w.x = pkh(a.x, a.y); w.y = pkh(a.z, a.w); w.z = pkh(b.x, b.y); w.w = pkh(b.z, b.w);
                    *(GAS u32x4*)(O + (size_t)row * 256 + col) = w;
                    asm volatile("" ::: "memory"); __builtin_amdgcn_sched_barrier(0);
                }
            }
    }
};

template <class Epi, class Sched, bool ALIGN_EPI = false, bool SP2 = false>
__device__ __forceinline__ void gemm_phase(LAS unsigned char* lds, const int tid, const Gemm g, const Sched& S, const Epi& E) {
    const int wid = __builtin_amdgcn_readfirstlane(tid >> 6), lane = tid & 63, wr = wid >> 2, wc = wid & 3, fr = lane & 15, fq = lane >> 4;
    const int K = g.K, nt = K / BK;
    unsigned voffA[2], voffB[2];
#pragma unroll
    for (int i = 0; i < 2; ++i) { int R, C; stage_rc(tid * 16 + i * 8192, R, C); const int Rb = Epi::PERM ? ((R & ~31) + perm32(R & 31)) : R;
        voffA[i] = (unsigned)(R * K + C) * 2u; voffB[i] = (unsigned)(Rb * K + C) * 2u; }
    const size_t kstep = (size_t)(BK * 2);
    const size_t hstep = (size_t)HALF * K * 2;
    const size_t tstep = 2 * hstep;
    const unsigned ldsw = (unsigned)wid * 1024u;
    const int aoff = lds_byte(wr * 64 + fr, fq * 8), boff = lds_byte(wc * 32 + fr, fq * 8);
#define PG8_SA(b, h) (((b) * 2 + (h)) * HTB)
#define PG8_SB(b, h) ((4 + (b) * 2 + (h)) * HTB)
#define PG8_STAGE(bufoff, gbase, voff) do { _Pragma("unroll") for (int _i = 0; _i < 2; ++_i) \
        __builtin_amdgcn_global_load_lds((const unsigned*)((const char*)(gbase) + (voff)[_i]), (LAS unsigned*)(lds + (bufoff) + ldsw + _i * 8192), 16, 0, 0); } while (0)
#define PG8_LDA(dst, b, h) do { _Pragma("unroll") for (int m = 0; m < 4; ++m) _Pragma("unroll") for (int k = 0; k < 2; ++k) dst[m][k] = *(const LAS half8*)(lds + PG8_SA(b, h) + aoff + m * 2048 + k * 1024); } while (0)
#define PG8_LDB(dst, b, h) do { _Pragma("unroll") for (int n = 0; n < 2; ++n) _Pragma("unroll") for (int k = 0; k < 2; ++k) dst[n][k] = *(const LAS half8*)(lds + PG8_SB(b, h) + boff + n * 2048 + k * 1024); } while (0)
#define PG8_MMA(ai, bj, At, Bt) do { __builtin_amdgcn_s_setprio(1); _Pragma("unroll") for (int m = 0; m < 4; ++m) _Pragma("unroll") for (int n = 0; n < 2; ++n) _Pragma("unroll") for (int k = 0; k < 2; ++k) \
        acc[ai][bj][m][n] = __builtin_amdgcn_mfma_f32_16x16x32_f16(Bt[n][k], At[m][k], acc[ai][bj][m][n], 0, 0, 0); __builtin_amdgcn_s_setprio(0); } while (0)
#define PG8_WAIT_V(n) asm volatile("s_waitcnt vmcnt(" #n ")" ::: "memory")
#define PG8_WAIT_L(n) asm volatile("s_waitcnt lgkmcnt(" #n ")" ::: "memory")
#define PG8_BAR __builtin_amdgcn_s_barrier()
#define PG8_SCHED __builtin_amdgcn_sched_barrier(0)
    Unit cur, nxt; int ui = 0;
    if (!S.next(0, cur)) return;
    f32x4 acc[2][2][4][2];
#pragma unroll
    for (int a = 0; a < 2; ++a)
#pragma unroll
        for (int b = 0; b < 2; ++b)
#pragma unroll
            for (int m = 0; m < 4; ++m)
#pragma unroll
                for (int n = 0; n < 2; ++n) acc[a][b][m][n] = (f32x4){0.f, 0.f, 0.f, 0.f};
    half8 At[4][2], B0[2][2], B1[2][2];
    const char* cA = (const char*)g.A + (size_t)cur.pm * tstep; const char* cB = (const char*)g.Bt + (size_t)cur.pn * tstep;
    if constexpr (SP2) {
        PG8_STAGE(PG8_SB(0, 0), cB, voffB); PG8_STAGE(PG8_SB(0, 1), cB + hstep, voffB); PG8_STAGE(PG8_SA(0, 0), cA, voffA); PG8_STAGE(PG8_SA(0, 1), cA + hstep, voffA);
        if (wr == 1) PG8_BAR;
        PG8_WAIT_V(2); PG8_BAR;
        PG8_STAGE(PG8_SB(1, 0), cB + kstep, voffB); PG8_STAGE(PG8_SA(1, 0), cA + kstep, voffA); PG8_STAGE(PG8_SB(1, 1), cB + hstep + kstep, voffB);
        PG8_WAIT_V(6); PG8_BAR;
    } else {
        PG8_STAGE(PG8_SB(0, 0), cB, voffB); PG8_STAGE(PG8_SA(0, 0), cA, voffA); PG8_STAGE(PG8_SB(0, 1), cB + hstep, voffB); PG8_STAGE(PG8_SA(0, 1), cA + hstep, voffA);
        if (wr == 1) PG8_BAR;
        PG8_WAIT_V(4); PG8_BAR;
        PG8_STAGE(PG8_SB(1, 0), cB + kstep, voffB); PG8_STAGE(PG8_SA(1, 0), cA + kstep, voffA); PG8_STAGE(PG8_SB(1, 1), cB + hstep + kstep, voffB);
        PG8_WAIT_V(6); PG8_BAR;
    }
    for (;;) {
        const bool has_next = S.next(ui + 1, nxt);
        const char* nA = has_next ? (const char*)g.A + (size_t)nxt.pm * tstep : cA; const char* nB = has_next ? (const char*)g.Bt + (size_t)nxt.pn * tstep : cB;
        for (int t = 0; t < nt; t += 2) {
            const bool last = (t == nt - 2);
            const char* a1 = cA + (size_t)(t + 1) * kstep;
            const char* a2 = last ? nA : cA + (size_t)(t + 2) * kstep; const char* b2 = last ? nB : cB + (size_t)(t + 2) * kstep;
            const char* a3 = a2 + kstep; const char* b3 = b2 + kstep;
            if constexpr (SP2) {
            PG8_LDB(B0, 0, 0); PG8_LDB(B1, 0, 1); PG8_SCHED; PG8_LDA(At, 0, 0); PG8_STAGE(PG8_SA(1, 1), a1 + hstep, voffA);
            PG8_WAIT_V(8); PG8_WAIT_L(0); PG8_BAR; PG8_MMA(0, 0, At, B0); PG8_MMA(0, 1, At, B1); PG8_BAR; PG8_SCHED;
            PG8_LDA(At, 0, 1); PG8_STAGE(PG8_SB(0, 0), b2, voffB); PG8_STAGE(PG8_SB(0, 1), b2 + hstep, voffB); PG8_STAGE(PG8_SA(0, 0), a2, voffA);
            PG8_WAIT_V(8); PG8_WAIT_L(0); PG8_BAR; PG8_MMA(1, 0, At, B0); PG8_MMA(1, 1, At, B1); PG8_BAR; PG8_SCHED;
            PG8_LDB(B0, 1, 0); PG8_LDB(B1, 1, 1); PG8_SCHED; PG8_LDA(At, 1, 0); PG8_STAGE(PG8_SA(0, 1), a2 + hstep, voffA);
            PG8_WAIT_V(8); PG8_WAIT_L(0); PG8_BAR; PG8_MMA(0, 0, At, B0); PG8_MMA(0, 1, At, B1); PG8_BAR; PG8_SCHED;
            PG8_LDA(At, 1, 1); PG8_STAGE(PG8_SB(1, 0), b3, voffB); PG8_STAGE(PG8_SB(1, 1), b3 + hstep, voffB); PG8_STAGE(PG8_SA(1, 0), a3, voffA);
            PG8_WAIT_V(8); PG8_WAIT_L(0); PG8_BAR; PG8_MMA(1, 0, At, B0); PG8_MMA(1, 1, At, B1); PG8_BAR; PG8_SCHED;
            } else {
            PG8_LDB(B0, 0, 0); PG8_SCHED; PG8_LDA(At, 0, 0); PG8_STAGE(PG8_SA(1, 1), a1 + hstep, voffA);
            PG8_WAIT_L(8); PG8_BAR; PG8_WAIT_L(0); PG8_MMA(0, 0, At, B0); PG8_BAR; PG8_SCHED;
            PG8_LDB(B1, 0, 1); PG8_STAGE(PG8_SB(0, 0), b2, voffB);
            PG8_BAR; PG8_WAIT_L(0); PG8_MMA(0, 1, At, B1); PG8_BAR;
            PG8_LDA(At, 0, 1); PG8_STAGE(PG8_SA(0, 0), a2, voffA);
            PG8_BAR; PG8_WAIT_L(0); PG8_MMA(1, 0, At, B0); PG8_BAR; PG8_SCHED;
            PG8_STAGE(PG8_SB(0, 1), b2 + hstep, voffB);
            PG8_WAIT_V(6); PG8_BAR; PG8_MMA(1, 1, At, B1); PG8_BAR;
            PG8_LDB(B0, 1, 0); PG8_SCHED; PG8_LDA(At, 1, 0); PG8_STAGE(PG8_SA(0, 1), a2 + hstep, voffA);
            PG8_WAIT_L(8); PG8_BAR; PG8_WAIT_L(0); PG8_MMA(0, 0, At, B0); PG8_BAR; PG8_SCHED;
            PG8_LDB(B1, 1, 1); PG8_STAGE(PG8_SB(1, 0), b3, voffB);
            PG8_BAR; PG8_WAIT_L(0); PG8_MMA(0, 1, At, B1); PG8_BAR;
            PG8_LDA(At, 1, 1); PG8_STAGE(PG8_SA(1, 0), a3, voffA);
            PG8_BAR; PG8_WAIT_L(0); PG8_MMA(1, 0, At, B0); PG8_BAR; PG8_SCHED;
            PG8_STAGE(PG8_SB(1, 1), b3 + hstep, voffB);
            PG8_WAIT_V(6); PG8_BAR; PG8_MMA(1, 1, At, B1); PG8_BAR;
            }
        }
        if constexpr (ALIGN_EPI) { if (wr == 0) PG8_BAR; }
        E(acc, cur, wr, wc, fr, fq);
        if (!has_next) break;
#pragma unroll
        for (int a = 0; a < 2; ++a)
#pragma unroll
            for (int b = 0; b < 2; ++b)
#pragma unroll
                for (int m = 0; m < 4; ++m)
#pragma unroll
                    for (int n = 0; n < 2; ++n) acc[a][b][m][n] = (f32x4){0.f, 0.f, 0.f, 0.f};
        cur = nxt; cA = nA; cB = nB; ++ui;
        if constexpr (ALIGN_EPI) { if (wr == 1) PG8_BAR; }
    }
    PG8_WAIT_V(0);
    if constexpr (!ALIGN_EPI) { if (wr == 0) PG8_BAR; }
    PG8_BAR;
#undef PG8_SA
#undef PG8_SB
#undef PG8_STAGE
#undef PG8_LDA
#undef PG8_LDB
#undef PG8_MMA
#undef PG8_WAIT_V
#undef PG8_WAIT_L
#undef PG8_BAR
#undef PG8_SCHED
}
}

constexpr size_t MiB = 1u << 20;
constexpr size_t WS_CTL = 0, CTL_ZERO_BYTES = 64 * 1024;
constexpr size_t WS_COS = 1 * MiB, WS_SIN = 1 * MiB + 512 * 1024;
constexpr size_t WS_PSUM = 2 * MiB;
constexpr size_t WS_WIN = 4 * MiB, WS_WOUT = 10 * MiB, WS_WUP = 12 * MiB, WS_WDN = 20 * MiB, WS_WC1 = 28 * MiB, WS_WC2 = 30 * MiB;
constexpr size_t WS_X16 = 32 * MiB;
constexpr size_t WS_O16 = 64 * MiB;
constexpr size_t WS_P = 96 * MiB;
constexpr size_t WS_U = 96 * MiB;
constexpr size_t WS_AC = 168 * MiB;
constexpr size_t WS_HC = 184 * MiB;
constexpr size_t WS_KVC = 186 * MiB;
constexpr size_t WS_MASK = 188 * MiB;
constexpr size_t WS_KIF = 196 * MiB;
constexpr size_t WS_END = 224 * MiB;
constexpr size_t WS_ALT = 220 * MiB;
constexpr int CW_BAR = 1024;

constexpr int RING_BYTES = 131072, WSCR_OFF = 131072, LDSCTL_OFF = 139264, MISC_OFF = LDSCTL_OFF + 64, LDS_BYTES = 147456;

#define XB_TMO      128
#define XB_XCNT(j)  (256  + 64 * (j))
#define XB_XSUB(j)  (1280 + 64 * (j))
#define XB_XGEN(j)  (2304 + 64 * (j))
#define XB_TOP      3328
#define XB_TOPGEN   3392
#define XCD_BAR_WORDS 3456
#define XB_SPIN_CAP (1u << 20)
__device__ __forceinline__ unsigned xb_ld(unsigned* p)              { return __hip_atomic_load(p, __ATOMIC_RELAXED, __HIP_MEMORY_SCOPE_AGENT); }
__device__ __forceinline__ unsigned xb_add(unsigned* p, unsigned v) { return __hip_atomic_fetch_add(p, v, __ATOMIC_RELAXED, __HIP_MEMORY_SCOPE_AGENT); }
__device__ __forceinline__ unsigned xb_xcc_id() { return (unsigned)__builtin_amdgcn_s_getreg((3 << 11) | 20) & 0xFu; }
#define XB_SPIN(cond, bar) do { unsigned _sp = 0; while (cond) { __builtin_amdgcn_s_sleep(1); \
    if ((++_sp & 255u) == 0u) { if (xb_ld(&(bar)[XB_TMO])) break; if (_sp > XB_SPIN_CAP) { atomicAdd(&(bar)[XB_TMO], 1u); break; } } } } while (0)
struct XcdBarrier { unsigned* bar; unsigned x; volatile LAS unsigned* st; };
__device__ __forceinline__ XcdBarrier xcd_barrier_post(unsigned* bar, volatile LAS unsigned* st) {
    XcdBarrier b; b.bar = bar; b.x = xb_xcc_id(); b.st = st;
    if (threadIdx.x == 0) (void)xb_add(&bar[XB_XCNT(b.x)], 1u);
    return b;
}
__device__ __forceinline__ void xcd_barrier_complete(unsigned* bar, unsigned x, unsigned& nloc, unsigned& nx) {
    const unsigned G = gridDim.x * gridDim.y * gridDim.z;
    unsigned sum, cnt, mine, sp = 0u;
    for (;;) {
        sum = 0u; cnt = 0u; mine = 0u;
#pragma unroll
        for (unsigned j = 0; j < 16; ++j) { const unsigned c = xb_ld(&bar[XB_XCNT(j)]); sum += c; cnt += (c > 0u) ? 1u : 0u; mine = (j == x) ? c : mine; }
        if (sum == G) break;
        __builtin_amdgcn_s_sleep(1);
        if ((++sp & 255u) == 0u) { if (xb_ld(&bar[XB_TMO])) break; if (sp > XB_SPIN_CAP) { atomicAdd(&bar[XB_TMO], 1u); break; } }
    }
    nloc = mine > 0u ? mine : 1u; nx = cnt > 0u ? cnt : 1u;
}
__device__ __forceinline__ void xcd_barrier(const XcdBarrier& b) {
    asm volatile("s_waitcnt vmcnt(0)" ::: "memory");
    __syncthreads();
    if (threadIdx.x == 0) {
        unsigned* bar = b.bar; asm volatile("" : "+s"(bar));
        __builtin_amdgcn_s_waitcnt(0);
        unsigned nloc = b.st[0], nx = b.st[1];
        if (nloc == 0u) { xcd_barrier_complete(bar, b.x, nloc, nx); b.st[0] = nloc; b.st[1] = nx; }
        const unsigned old = xb_add(&bar[XB_XSUB(b.x)], 1u);
        const unsigned gen = old / nloc;
        if (old + 1u == (gen + 1u) * nloc) {
            __builtin_amdgcn_fence(__ATOMIC_RELEASE, "agent");
            asm volatile("s_waitcnt vmcnt(0)" ::: "memory");
            const unsigned og = xb_add(&bar[XB_TOP], 1u);
            const unsigned tg = og / nx;
            if (og + 1u == (tg + 1u) * nx) xb_add(&bar[XB_TOPGEN], 1u);
            else XB_SPIN(xb_ld(&bar[XB_TOPGEN]) == tg, bar);
            __builtin_amdgcn_fence(__ATOMIC_ACQUIRE, "agent");
            xb_add(&bar[XB_XGEN(b.x)], 1u);
            asm volatile("s_waitcnt vmcnt(0)" ::: "memory");
        } else {
            XB_SPIN(xb_ld(&bar[XB_XGEN(b.x)]) == gen, bar);
            __builtin_amdgcn_fence(__ATOMIC_ACQUIRE, "agent");
            asm volatile("s_waitcnt vmcnt(0)" ::: "memory");
        }
    }
    __syncthreads();
}

struct Args {
    const float* x; const float* mix_g; const float* mlp_g; const float* even_w_in; const float* even_pe; const float* even_w1; const float* even_w2; const float* even_w_out;
    const float* odd_w_in; const float* odd_lambda; const float* odd_subln; const float* odd_w_out; const float* mlp_up; const float* mlp_down; const float* final_g;
    float* out; unsigned char* ws; int ph_lo, ph_hi;
};
typedef const __attribute__((address_space(4))) Args* ArgsP;
struct Frame {
    LAS unsigned char* lds; int tid, lane, wave, G, bid;
    ArgsP a; unsigned char* ws;
};
__device__ __forceinline__ ArgsP kargs() { ArgsP p = (ArgsP)__builtin_amdgcn_kernarg_segment_ptr(); asm volatile("" : "+s"(p)); return p; }

enum { K_PREP = 0, K_INPROJ, K_PRE, K_CMP1, K_CMP2, K_ATTN, K_OUTPROJ, K_UP, K_DOWN, K_FINAL };
constexpr int NPHASE = 26;
__host__ __device__ __forceinline__ void phase_decode(int ph, int& layer, int& kind) {
    if (ph >= 25) { layer = 4; kind = K_FINAL; return; }
    if (ph < 8) { layer = 0; kind = (ph < 4) ? ph : ph + 1; return; }
    int base;
    if (ph < 13) { layer = 1; base = 8; } else if (ph < 20) { layer = 2; base = 13; } else { layer = 3; base = 20; }
    const int i = ph - base;
    if (layer & 1) kind = (i == 0) ? K_INPROJ : (i == 1) ? K_ATTN : (i == 2) ? K_OUTPROJ : (i == 3) ? K_UP : K_DOWN;
    else kind = (i < 3) ? i + 1 : i + 2;
}

__device__ __forceinline__ int storage_row(int c) {
    const int head = c >> 6, d = c & 63;
    const int s = (d < 32) ? ((d >> 2) * 8 + (d & 3)) : (((d - 32) >> 2) * 8 + 4 + (d & 3));
    return head * 64 + s;
}
template <int MAP>
__device__ __forceinline__ void conv_weight(const Frame& F, const float* src, int K, int N, u16* dst, const float* gain) {
    const int gtid = F.bid * 512 + F.tid, GT = F.G * 512;
    const int total = N * (K / 8);
    for (int i0 = gtid; i0 < total; i0 += 2 * GT) {
        float v[2][8]; int nn[2], kk[2]; bool ok[2];
#pragma unroll
        for (int c = 0; c < 2; ++c) { const int i = i0 + c * GT; ok[c] = i < total; const int ii = ok[c] ? i : i0; nn[c] = ii % N; kk[c] = (ii / N) * 8;
#pragma unroll
            for (int j = 0; j < 8; ++j) v[c][j] = ((const GAS float*)src)[(size_t)(kk[c] + j) * N + nn[c]]; }
#pragma unroll
        for (int c = 0; c < 2; ++c) {
            if (gain) {
#pragma unroll
                for (int j = 0; j < 8; ++j) v[c][j] *= ((const GAS float*)gain)[kk[c] + j]; }
            int r = nn[c];
            if (MAP == 1) { int cc = nn[c];
                if (cc >= 960 && cc < 964) cc = cc - 960 + C_WI;
                else if (cc >= 964 && cc < 1476) cc = cc - 4;
                else if (cc >= 1476 && cc < 2244) { const int j = cc - 1476, idx = j >> 7, gg = (j >> 6) & 1, d = j & 63;
                    cc = (idx < 4) ? (C_KVB + j) : (idx == 4) ? ((gg ? C_KW1 : C_KW0) + d) : (C_VW + gg * 64 + d); }
                else if (cc >= 2244) cc = cc - 2244 + C_GB;
                r = storage_row(cc); }
            if (MAP == 2) r = storage_row(nn[c]);
            u32x4 w; w.x = pkh(v[c][0], v[c][1]); w.y = pkh(v[c][2], v[c][3]); w.z = pkh(v[c][4], v[c][5]); w.w = pkh(v[c][6], v[c][7]);
            if (ok[c]) *(GAS u32x4*)(dst + (size_t)r * K + kk[c]) = w;
        }
    }
}

__device__ __forceinline__ void prep_phase(const Frame& F, int layer) {
    const ArgsP ap = F.a; unsigned char* ws = F.ws;
    unsigned char* wb = ws + ((layer & 1) ? WS_ALT : (size_t)0);
    const int gtid = F.bid * 512 + F.tid, GT = F.G * 512;
    if (layer == 0) {
        float* cosT = (float*)(ws + WS_COS); float* sinT = (float*)(ws + WS_SIN);
        for (int i = gtid; i < T * 32; i += GT) {
            const int t = i >> 5, k = i & 31;
            const float ang = (float)t * ROPE_INV[k];
            double r = (double)ang * 0.15915494309189535; r -= rint(r);
            cosT[i] = __builtin_amdgcn_cosf((float)r); sinT[i] = __builtin_amdgcn_sinf((float)r);
        }
        const int gw = F.bid * 8 + F.wave, NGW = F.G * 8;
        float* psum = (float*)(ws + WS_PSUM); u16* x16 = (u16*)(ws + WS_X16);
        for (int row = gw; row < M; row += NGW) {
            const f32x4* xr = (const f32x4*)(G(ap->x) + (size_t)row * DM) + F.lane;
            u32x2* hrow = (u32x2*)(x16 + (size_t)row * DM) + F.lane;
            float s = 0.f;
#pragma unroll
            for (int j = 0; j < 4; ++j) { const f32x4 v = xr[64 * j]; s += (v.x * v.x + v.y * v.y) + (v.z * v.z + v.w * v.w);
                u32x2 w; w.x = pkh(v.x, v.y); w.y = pkh(v.z, v.w); hrow[64 * j] = w; }
            s = wave_sum(s);
            if (F.lane < 16) psum[(size_t)row * 16 + F.lane] = (F.lane == 0) ? s : 0.f;
        }
    }
    const int e = layer >> 1;
    if (layer & 1) {
        conv_weight<2>(F, G(ap->odd_w_in) + (size_t)e * DM * ODD_N, DM, ODD_N, (u16*)(wb + WS_WIN), G(ap->mix_g) + layer * DM);
        conv_weight<0>(F, G(ap->odd_w_out) + (size_t)e * DM * DM, DM, DM, (u16*)(wb + WS_WOUT), nullptr);
    } else {
        conv_weight<1>(F, G(ap->even_w_in) + (size_t)e * DM * 2268, DM, 2268, (u16*)(wb + WS_WIN), G(ap->mix_g) + layer * DM);
        conv_weight<0>(F, G(ap->even_w_out) + (size_t)e * DM * DM, DM, DM, (u16*)(wb + WS_WOUT), nullptr);
        conv_weight<0>(F, G(ap->even_w1) + (size_t)(e * 2 + 0) * 2048 * 256, 2048, 256, (u16*)(ws + WS_WC1), nullptr);
        conv_weight<0>(F, G(ap->even_w1) + (size_t)(e * 2 + 1) * 2048 * 256, 2048, 256, (u16*)(ws + WS_WC1) + (size_t)256 * 2048, nullptr);
        conv_weight<0>(F, G(ap->even_w2) + (size_t)(e * 2 + 0) * 256 * 64, 256, 64, (u16*)(ws + WS_WC2), nullptr);
        conv_weight<0>(F, G(ap->even_w2) + (size_t)(e * 2 + 1) * 256 * 64, 256, 64, (u16*)(ws + WS_WC2) + (size_t)256 * 256, nullptr);
    }
    conv_weight<0>(F, G(ap->mlp_up) + (size_t)layer * DM * DFF, DM, DFF, (u16*)(wb + WS_WUP), G(ap->mlp_g) + layer * DM);
    conv_weight<0>(F, G(ap->mlp_down) + (size_t)layer * DFF * DM, DFF, DM, (u16*)(wb + WS_WDN), nullptr);
}

__device__ __forceinline__ unsigned sortable(float f) {
    if (f == 0.f) f = 0.f;
    const unsigned b = __float_as_uint(f);
    return (b & 0x80000000u) ? ~b : (b | 0x80000000u);
}
__device__ __forceinline__ int wave_isum(int v) {
#pragma unroll
    for (int o = 1; o < 64; o <<= 1) v += __shfl_xor(v, o);
    return v;
}
__device__ __forceinline__ void select_row(LAS unsigned* ub, int t, u64* maskrow, int lane, LAS unsigned* wscr) {
    unsigned u[64];
#pragma unroll
    for (int j = 0; j < 64; ++j) { const int s = j * 64 + lane; const unsigned v = ub[s]; u[j] = (s <= t) ? v : 0u; }
    const int n = t + 1;
    unsigned L = 1u;
    if (n > 704) {
        int ns = 0;
#pragma unroll
        for (int i = 0; i < 8; ++i) { int c = n - 512 * i; c = c < 0 ? 0 : (c > 64 ? 64 : c); ns += c; }
        const int cs_lo = (380 * ns + n - 1) / n, cs_hi = (620 * ns) / n;
        unsigned ts = 0u;
        for (int bit = 31; bit >= 0; --bit) {
            const unsigned cand = ts | (1u << bit);
            int cs = 0;
#pragma unroll
            for (int i = 0; i < 8; ++i) cs += __popcll(__ballot(u[8 * i] >= cand));
            if (cs >= cs_lo) { ts = cand; if (cs <= cs_hi) break; }
        }
        L = ts > 1u ? ts : 1u;
    }
    int C = 0;
    LAS unsigned* wl = wscr;
    bool listed = false;
    asm volatile("s_waitcnt lgkmcnt(0)" ::: "memory");
#pragma unroll
    for (int j = 0; j < 64; ++j) {
        const bool pr = u[j] >= L; const u64 bal = __ballot(pr);
        const int pos = C + (int)__builtin_amdgcn_mbcnt_hi((unsigned)(bal >> 32), __builtin_amdgcn_mbcnt_lo((unsigned)bal, 0u));
        const int slot = (pr && pos < 704) ? pos : 704 + lane;
        ub[slot] = u[j]; ub[1024 + slot] = (unsigned)(j * 64 + lane);
        C += __popcll(bal);
    }
    asm volatile("s_waitcnt lgkmcnt(0)" ::: "memory");
    unsigned thr = 0u; int need;
    if (C >= 256 && C <= 704) {
        unsigned v[11];
#pragma unroll
        for (int i = 0; i < 11; ++i) { const int p = i * 64 + lane; const unsigned x = ub[p]; v[i] = (p < C) ? x : 0u; }
        bool exact = false;
        for (int bit = 31; bit >= 0; --bit) {
            const unsigned cand = thr | (1u << bit);
            int cnt = 0;
#pragma unroll
            for (int i = 0; i < 11; ++i) cnt += __popcll(__ballot(v[i] >= cand));
            if (cnt >= 256) { thr = cand; if (cnt == 256) { exact = true; break; } }
        }
        if (exact) need = 1 << 20;
        else { int cg = 0, cge = 0;
#pragma unroll
            for (int i = 0; i < 11; ++i) { cg += __popcll(__ballot(v[i] > thr)); cge += __popcll(__ballot(v[i] >= thr)); }
            need = (cge == 256) ? (1 << 20) : 256 - cg; }
        { unsigned id[11];
#pragma unroll
          for (int i = 0; i < 11; ++i) id[i] = ub[1024 + i * 64 + lane];
          int base = 0;
          if (need >= (1 << 20)) {
#pragma unroll
              for (int i = 0; i < 11; ++i) { const bool mine = v[i] >= thr; const u64 sel = __ballot(mine);
                  const int pos = base + (int)__builtin_amdgcn_mbcnt_hi((unsigned)(sel >> 32), __builtin_amdgcn_mbcnt_lo((unsigned)sel, 0u));
                  if (mine) wl[pos & 255] = id[i];
                  base += __popcll(sel); }
          } else {
              int nd = need;
#pragma unroll
              for (int i = 0; i < 11; ++i) { const u64 gt = __ballot(v[i] > thr); u64 eq = __ballot(v[i] == thr); int c = __popcll(eq);
                  while (c > nd) { eq &= ~(1ull << (63 - __clzll(eq))); --c; }
                  nd -= c; const u64 sel = gt | eq;
                  const int pos = base + (int)__builtin_amdgcn_mbcnt_hi((unsigned)(sel >> 32), __builtin_amdgcn_mbcnt_lo((unsigned)sel, 0u));
                  if ((sel >> lane) & 1ull) wl[pos & 255] = id[i];
                  base += __popcll(sel); } }
          listed = true; }
    } else {
        bool exact = false;
        for (int bit = 31; bit >= 0; --bit) {
            const unsigned cand = thr | (1u << bit);
            int c0 = 0, c1 = 0;
#pragma unroll
            for (int j = 0; j < 64; j += 2) { c0 += (u[j] >= cand) ? 1 : 0; c1 += (u[j + 1] >= cand) ? 1 : 0; }
            const int cnt = wave_isum(c0 + c1);
            if (cnt >= 256) { thr = cand; if (cnt == 256) { exact = true; break; } }
        }
        if (exact) need = 1 << 20;
        else { int cg = 0, cge = 0;
#pragma unroll
            for (int j = 0; j < 64; ++j) { cg += (u[j] > thr) ? 1 : 0; cge += (u[j] >= thr) ? 1 : 0; }
            need = (wave_isum(cge) == 256) ? (1 << 20) : 256 - wave_isum(cg); }
    }
    if (!listed) {
        int base = 0; const int nd0 = __builtin_amdgcn_readfirstlane(need);
        if (nd0 >= (1 << 20)) {
#pragma unroll
            for (int j = 0; j < 64; ++j) { const bool mine = u[j] >= thr; const u64 sel = __ballot(mine);
                const int pos = base + (int)__builtin_amdgcn_mbcnt_hi((unsigned)(sel >> 32), __builtin_amdgcn_mbcnt_lo((unsigned)sel, 0u));
                if (mine) wl[pos & 255] = (unsigned)(j * 64 + lane);
                base += __popcll(sel); }
        } else {
            int nd = nd0;
#pragma unroll
            for (int j = 0; j < 64; ++j) { const u64 gt = __ballot(u[j] > thr); u64 eq = __ballot(u[j] == thr); int c = __popcll(eq);
                while (c > nd) { eq &= ~(1ull << (63 - __clzll(eq))); --c; }
                nd -= c; const u64 sel = gt | eq;
                const int pos = base + (int)__builtin_amdgcn_mbcnt_hi((unsigned)(sel >> 32), __builtin_amdgcn_mbcnt_lo((unsigned)sel, 0u));
                if ((sel >> lane) & 1ull) wl[pos & 255] = (unsigned)(j * 64 + lane);
                base += __popcll(sel); } }
    }
    asm volatile("s_waitcnt lgkmcnt(0)" ::: "memory");
    { const u32x4 e4 = ((const LAS u32x4*)wl)[lane];
      ((GAS u64*)maskrow)[lane] = (u64)(e4.x | (e4.y << 16)) | ((u64)(e4.z | (e4.w << 16)) << 32); }
}

template <int DV, class Valid>
__device__ __forceinline__ void naive_attn(const u16* qp, const u16* Kb, int kp, const u16* Vb, int vp, int s_lo, int s_hi, Valid valid, LAS float* pbuf, int lane, float (&o)[DV / 64], float& inv) {
    float q[64];
#pragma unroll
    for (int c = 0; c < 8; ++c) unpack8(*(const GAS u32x4*)(qp + c * 8), q + c * 8);
    const int base = s_lo & ~63;
    float mx = -INFINITY;
    for (int s0 = base; s0 <= s_hi; s0 += 64) {
        const int s = s0 + lane; float sc = -INFINITY;
        if (s >= s_lo && s <= s_hi && valid(s)) {
            const u32x4* kr = (const u32x4*)(Kb + (size_t)s * kp); sc = 0.f;
#pragma unroll
            for (int c = 0; c < 8; ++c) { float kf[8]; unpack8(kr[c], kf);
#pragma unroll
                for (int i = 0; i < 8; ++i) sc += q[c * 8 + i] * kf[i]; }
        }
        pbuf[s - base] = sc; mx = fmaxf(mx, sc);
    }
    mx = wave_max(mx);
#pragma unroll
    for (int i = 0; i < DV / 64; ++i) o[i] = 0.f;
    inv = 0.f;
    if (mx == -INFINITY) return;
    float sum = 0.f; u64 anym = 0ull;
    for (int s0 = base; s0 <= s_hi; s0 += 64) {
        const float p = __builtin_amdgcn_exp2f(pbuf[s0 - base + lane] - mx);
        pbuf[s0 - base + lane] = p; sum += p;
        if (__ballot(p > 0.f)) anym |= 1ull << ((s0 - base) >> 6);
    }
    sum = wave_sum(sum); inv = 1.0f / sum;
    const int nch = ((s_hi - base) >> 6) + 1;
    for (int ch = 0; ch < nch; ++ch) {
        if (!((anym >> ch) & 1ull)) continue;
        const LAS float* pp = pbuf + ch * 64; const u16* vr = Vb + (size_t)(base + ch * 64) * vp + lane;
#pragma unroll 8
        for (int i = 0; i < 64; ++i) {
            const float p = pp[i];
#pragma unroll
            for (int j = 0; j < DV / 64; ++j) o[j] += p * h2f(vr[(size_t)i * vp + 64 * j]);
        }
    }
#pragma unroll
    for (int i = 0; i < DV / 64; ++i) o[i] *= inv;
}

__device__ __forceinline__ void idx_unit(const Frame& F, int b, int qb8) {
    typedef float f32x16_ __attribute__((ext_vector_type(16)));
    const int lane = F.lane, wave = F.wave, r32 = lane & 31, hi = lane >> 5;
    unsigned char* ws = F.ws;
    const u16* Pb = (const u16*)(ws + WS_P) + (size_t)b * T * EVEN_N;
    u64* MASK = (u64*)(ws + WS_MASK) + (size_t)(b * T) * 64;
    const u16* KIF = (const u16*)(ws + WS_KIF);
    const int t0 = qb8 * 8;
    if (t0 + 7 < 256) {
        const int t = t0 + wave; u64 v = 0ull;
#pragma unroll
        for (int q = 0; q < 4; ++q) { const int e = 4 * lane + q; v |= (u64)((e <= t) ? e : 0) << (16 * q); }
        ((GAS u64*)MASK)[(size_t)t * 64 + lane] = v; return;
    }
    LAS unsigned* ub = (LAS unsigned*)F.lds;
    half8 qa[4];
    { const u16* qp = Pb + (size_t)(t0 + (r32 >> 2)) * EVEN_N + C_QI + (r32 & 3) * 64 + hi * 8;
#pragma unroll
      for (int ks = 0; ks < 4; ++ks) qa[ks] = *(const GAS half8*)(qp + ks * 16); }
    float wq[4][4];
#pragma unroll
    for (int i = 0; i < 4; ++i) { const u32x2 w2 = *(const GAS u32x2*)(Pb + (size_t)(t0 + 2 * i + hi) * EVEN_N + C_WI);
        wq[i][0] = h2f(w2.x & 0xffffu); wq[i][1] = h2f(w2.x >> 16); wq[i][2] = h2f(w2.y & 0xffffu); wq[i][3] = h2f(w2.y >> 16); }
    const int nt32 = ((t0 + 7) >> 5) + 1;
    for (int kt0 = wave; kt0 < nt32; kt0 += 64) {
        half8 kb[8][4];
#pragma unroll
        for (int u = 0; u < 8; ++u) { const int kt = (kt0 + 8 * u < nt32) ? kt0 + 8 * u : kt0;
            const u16* kp = KIF + ((size_t)(b * (T / 32) + kt) * 8 * 32 + lane) * 8;
#pragma unroll
            for (int ks = 0; ks < 4; ++ks) kb[u][ks] = *(const GAS half8*)(kp + (size_t)ks * 64 * 8); }
#pragma unroll
        for (int u = 0; u < 8; ++u) {
            const int kt = kt0 + 8 * u;
            if (kt < nt32) {
                f32x16_ c = {0.f, 0.f, 0.f, 0.f, 0.f, 0.f, 0.f, 0.f, 0.f, 0.f, 0.f, 0.f, 0.f, 0.f, 0.f, 0.f};
#pragma unroll
                for (int ks = 0; ks < 4; ++ks) c = __builtin_amdgcn_mfma_f32_32x32x16_f16(qa[ks], kb[u][ks], c, 0, 0, 0);
#pragma unroll
                for (int i = 0; i < 4; ++i) {
                    const float sc = wq[i][0] * fmaxf(c[4 * i], 0.f) + wq[i][1] * fmaxf(c[4 * i + 1], 0.f) + wq[i][2] * fmaxf(c[4 * i + 2], 0.f) + wq[i][3] * fmaxf(c[4 * i + 3], 0.f);
                    ub[(2 * i + hi) * 4096 + kt * 32 + r32] = sortable(sc);
                }
            }
        }
    }
    __syncthreads();
    select_row(ub + wave * 4096, t0 + wave, MASK + (size_t)(t0 + wave) * 64, lane, (LAS unsigned*)(F.lds + WSCR_OFF + wave * 1024));
    __syncthreads();
}

__device__ __forceinline__ void pre_phase(const Frame& F, int layer) {
    const ArgsP ap = F.a; unsigned char* ws = F.ws; const int e = layer >> 1;
    const u16* P = (const u16*)(ws + WS_P);
    const int gtid = F.bid * 512 + F.tid, GT = F.G * 512;
    u16* AC = (u16*)(ws + WS_AC);
    for (int i = gtid; i < 2 * 4 * 2 * 256 * 256; i += GT) {
        const int ch = i & 255, n = (i >> 8) & 255, g = (i >> 16) & 1, b = (i >> 17) & 3, kv = i >> 19;
        const int l = ch >> 3, d0 = (ch & 7) * 8;
        u32x4 w = (u32x4){0u, 0u, 0u, 0u};
        if (n < 255) {
            float f[8]; unpack8(*(const GAS u32x4*)(P + (size_t)(b * T + 16 * n + l) * EVEN_N + C_KC + kv * 128 + g * 64 + d0), f);
            const float* pe = G(ap->even_pe) + ((size_t)(e * 2 + kv) * 32 + l) * 64 + d0;
#pragma unroll
            for (int j = 0; j < 8; ++j) f[j] += pe[j];
            w.x = pkh(f[0], f[1]); w.y = pkh(f[2], f[3]); w.z = pkh(f[4], f[5]); w.w = pkh(f[6], f[7]);
        }
        *(GAS u32x4*)(AC + (size_t)i * 8) = w;
    }
    __syncthreads();
    if (F.G == 256) { for (int i = 0; i < 8; ++i) idx_unit(F, i >> 1, (i & 1) ? 511 - F.bid : F.bid); }
}

typedef float f32x16 __attribute__((ext_vector_type(16)));
typedef short v4i16 __attribute__((ext_vector_type(4)));
constexpr int A_KB = 0, A_VB = 32768, A_AUX = 65536;
constexpr float NEG_BIG = -1.0e30f;
__device__ __forceinline__ constexpr int crow(int r, int hi) { return (r & 3) + 8 * (r >> 2) + 4 * hi; }

template <int KD> __device__ __forceinline__ int kswz(int row, int chunk) { return (KD == 64) ? (chunk ^ ((row >> 1) & 7)) : (chunk ^ (row & 15)); }
template <int KD> __device__ __forceinline__ void stage_load_k(u32x4 (&kr)[KD / 64], const u16* Kg, int pitch, int tid) {
#pragma unroll
    for (int i = 0; i < KD / 64; ++i) { const int p = tid + 512 * i, row = p / (KD / 8), ch = p % (KD / 8);
        kr[i] = *(const GAS u32x4*)(Kg + (size_t)row * pitch + ch * 8); }
}
template <int KD> __device__ __forceinline__ void stage_write_k(LAS unsigned char* kb, const u32x4 (&kr)[KD / 64], int tid) {
#pragma unroll
    for (int i = 0; i < KD / 64; ++i) { const int p = tid + 512 * i, row = p / (KD / 8), ch = p % (KD / 8);
        *(LAS u32x4*)(kb + row * (KD * 2) + kswz<KD>(row, ch) * 16) = kr[i]; }
}
template <int DV> __device__ __forceinline__ void stage_load_v(u32x4 (&vr)[DV / 64], const u16* Vg, int pitch, int wave, int lane) {
#pragma unroll
    for (int i = 0; i < DV / 64; ++i) { const int p = wave + 8 * i, dh = p >> 2, rg = p & 3;
        vr[i] = *(const GAS u32x4*)(Vg + (size_t)(16 * rg + (lane >> 2)) * pitch + dh * 32 + (lane & 3) * 8); }
}
template <int DV> __device__ __forceinline__ void stage_write_v(LAS unsigned char* vb, const u32x4 (&vr)[DV / 64], int wave, int lane) {
#pragma unroll
    for (int i = 0; i < DV / 64; ++i) *(LAS u32x4*)(vb + (wave + 8 * i) * 1024 + lane * 16) = vr[i];
}
template <int KD, int VAR = 0> __device__ __forceinline__ void qk_tile(f32x16& p0, f32x16& p1, const LAS unsigned char* kbuf, int chunk0, int r32, int hi, const half8 (&qr)[4], const f32x16& z) {
    const LAS unsigned char* kb = kbuf + r32 * (KD * 2);
    half8 b0[4], b1[4];
#pragma unroll
    for (int d0 = 0; d0 < 4; ++d0) {
        const int off = kswz<KD>(r32, chunk0 + 2 * d0 + hi) * 16;
        b0[d0] = *(const LAS half8*)(kb + off); b1[d0] = *(const LAS half8*)(kb + 32 * (KD * 2) + off);
    }
    __builtin_amdgcn_sched_barrier(0);
    if (VAR == 3) { p0 = z; p1 = z; p0[0] = (float)b0[0][0] + (float)b1[1][0] + (float)b0[2][0] + (float)b1[3][0]; p1[0] = (float)b1[0][0] + (float)b0[1][0] + (float)b1[2][0] + (float)b0[3][0]; return; }
#pragma unroll
    for (int d0 = 0; d0 < 4; ++d0) {
        p0 = __builtin_amdgcn_mfma_f32_32x32x16_f16(b0[d0], qr[d0], d0 ? p0 : z, 0, 0, 0);
        p1 = __builtin_amdgcn_mfma_f32_32x32x16_f16(b1[d0], qr[d0], d0 ? p1 : z, 0, 0, 0);
    }
}
__device__ __forceinline__ float swap_max(float m) { auto rr = __builtin_amdgcn_permlane32_swap(__float_as_uint(m), __float_as_uint(m), false, false); return fmaxf(__uint_as_float(rr[0]), __uint_as_float(rr[1])); }
__device__ __forceinline__ float swap_sum(float m) { auto rr = __builtin_amdgcn_permlane32_swap(__float_as_uint(m), __float_as_uint(m), false, false); return __uint_as_float(rr[0]) + __uint_as_float(rr[1]); }
__device__ __forceinline__ float max3f(float a, float b, float c) { float r; asm("v_max3_f32 %0, %1, %2, %3" : "=v"(r) : "v"(a), "v"(b), "v"(c)); return r; }
typedef float f32x2 __attribute__((ext_vector_type(2)));
template <int DV> __device__ __forceinline__ void softmax_tile(f32x16& p0, f32x16& p1, float& m, int& started, f32x16& negm, float& l, f32x16 (&o)[DV / 32], LAS float* wsf, int r32, int hi, u32x4 (&pw)[4]) {
    asm volatile("s_nop 7\n\ts_nop 7\n\ts_nop 7" : "+v"(p0), "+v"(p1));
    float a = max3f(p0[0], p0[1], p1[0]), b = max3f(p0[2], p0[3], p1[1]); a = max3f(a, p1[2], p1[3]);
#pragma unroll
    for (int r = 4; r < 16; r += 4) { a = max3f(a, p0[r], p0[r + 1]); b = max3f(b, p0[r + 2], p0[r + 3]); a = max3f(a, p1[r], p1[r + 1]); b = max3f(b, p1[r + 2], p1[r + 3]); }
    const float rm = swap_max(max3f(a, b, b));
    const bool first = (started == 0) && (rm > -INFINITY);
    if (__any(first || rm > 8.0f)) {
        float delta = 0.f, f = 1.f;
        if (first) { delta = rm; started = 1; }
        else if (started && rm > 8.0f) { delta = rm; f = __builtin_amdgcn_exp2f(-rm); }
        m += delta; l *= f;
#pragma unroll
        for (int r = 0; r < 16; ++r) { p0[r] -= delta; p1[r] -= delta; negm[r] = -m; }
        if (hi == 0) wsf[r32] = f;
        asm volatile("s_waitcnt lgkmcnt(0)" ::: "memory");
#pragma unroll
        for (int r = 0; r < 16; ++r) { const float fr_ = wsf[crow(r, hi)];
#pragma unroll
            for (int d0 = 0; d0 < DV / 32; ++d0) o[d0][r] *= fr_; }
    }
    f32x2 s2 = {0.f, 0.f};
#pragma unroll
    for (int r = 0; r < 16; r += 2) {
        p0[r] = __builtin_amdgcn_exp2f(p0[r]); p0[r + 1] = __builtin_amdgcn_exp2f(p0[r + 1]); p1[r] = __builtin_amdgcn_exp2f(p1[r]); p1[r + 1] = __builtin_amdgcn_exp2f(p1[r + 1]);
        s2 += (f32x2){p0[r], p0[r + 1]}; s2 += (f32x2){p1[r], p1[r + 1]};
    }
    l += s2.x + s2.y;
    pw[0] = (u32x4){pkh(p0[0], p0[1]), pkh(p0[2], p0[3]), pkh(p0[4], p0[5]), pkh(p0[6], p0[7])};
    pw[1] = (u32x4){pkh(p0[8], p0[9]), pkh(p0[10], p0[11]), pkh(p0[12], p0[13]), pkh(p0[14], p0[15])};
    pw[2] = (u32x4){pkh(p1[0], p1[1]), pkh(p1[2], p1[3]), pkh(p1[4], p1[5]), pkh(p1[6], p1[7])};
    pw[3] = (u32x4){pkh(p1[8], p1[9]), pkh(p1[10], p1[11]), pkh(p1[12], p1[13]), pkh(p1[14], p1[15])};
}
__device__ __forceinline__ v4i16 vtr(const LAS unsigned char* p) { return __builtin_amdgcn_ds_read_tr16_b64_v4i16((LAS v4i16*)p); }
struct VFrag { v4i16 lo[2][2], hh[2][2]; };
__device__ __forceinline__ void v_group_load(VFrag& f, const LAS unsigned char* vb, int g) {
    const int dp = g >> 1, kh = g & 1;
#pragma unroll
    for (int e = 0; e < 2; ++e)
#pragma unroll
        for (int k2 = 0; k2 < 2; ++k2) { const int ks = 2 * kh + k2; f.lo[e][k2] = vtr(vb + (2 * dp + e) * 4096 + ks * 1024); f.hh[e][k2] = vtr(vb + (2 * dp + e) * 4096 + ks * 1024 + 512); }
}
template <int DV> __device__ __forceinline__ void v_group_mma(f32x16 (&o)[DV / 32], const VFrag& f, const u32x4 (&pw)[4], int g) {
    const int dp = g >> 1, kh = g & 1;
#pragma unroll
    for (int k2 = 0; k2 < 2; ++k2)
#pragma unroll
        for (int e = 0; e < 2; ++e) {
            const s16x8 vf = {f.lo[e][k2][0], f.lo[e][k2][1], f.lo[e][k2][2], f.lo[e][k2][3], f.hh[e][k2][0], f.hh[e][k2][1], f.hh[e][k2][2], f.hh[e][k2][3]};
            o[2 * dp + e] = __builtin_amdgcn_mfma_f32_32x32x16_f16(__builtin_bit_cast(half8, pw[2 * kh + k2]), __builtin_bit_cast(half8, vf), o[2 * dp + e], 0, 0, 0);
        }
}
template <int DV> __device__ __forceinline__ void pv_tile(f32x16 (&o)[DV / 32], const LAS unsigned char* vb, const u32x4 (&pw)[4], VFrag& fA) {
    VFrag fB;
    v_group_load(fB, vb, 1); __builtin_amdgcn_sched_barrier(0);
    v_group_mma<DV>(o, fA, pw, 0); __builtin_amdgcn_sched_barrier(0);
    if (DV == 128) {
        v_group_load(fA, vb, 2); __builtin_amdgcn_sched_barrier(0);
        v_group_mma<DV>(o, fB, pw, 1); __builtin_amdgcn_sched_barrier(0);
        v_group_load(fB, vb, 3); __builtin_amdgcn_sched_barrier(0);
        v_group_mma<DV>(o, fA, pw, 2); __builtin_amdgcn_sched_barrier(0);
        v_group_mma<DV>(o, fB, pw, 3); __builtin_amdgcn_sched_barrier(0);
    } else {
        v_group_mma<DV>(o, fB, pw, 1); __builtin_amdgcn_sched_barrier(0);
    }
}
__device__ __forceinline__ int vtr_lane_off(int lane) { const int hi = lane >> 5; return ((lane >> 4) & 1) * 32 + (lane & 3) * 8 + (4 * hi + ((lane & 15) >> 2)) * 64; }
__device__ __forceinline__ void finalize_rows(float l, float gate, LAS float* wsf, int r32, int hi, float (&rli)[16]) {
    l = swap_sum(l);
    if (hi == 0) wsf[32 + r32] = gate / fmaxf(l, 1e-30f);
    asm volatile("s_waitcnt lgkmcnt(0)" ::: "memory");
#pragma unroll
    for (int r = 0; r < 16; ++r) rli[r] = wsf[32 + crow(r, hi)];
    asm volatile("s_waitcnt lgkmcnt(0)" ::: "memory");
}

template <int KD, int DV, int MODE, int VAR = 0>
__device__ __forceinline__ void attn_range_loop(const Frame& F, const u16* Kg, int kpitch, int kchunk0, const u16* Vg, int vpitch, u64 tiles, int kmax, int kmin, u64 rowsel, const LAS u64* ml,
                                                const half8 (&qr)[4], f32x16 (&o)[DV / 32], float& m, float& l) {
    const int lane = F.lane, wave = F.wave, r32 = lane & 31, hi = lane >> 5;
    LAS float* wsf = (LAS float*)(F.lds + WSCR_OFF + wave * 1024);
    m = 0.f; l = 0.f; int started = 0;
    f32x16 negm = {0.f, 0.f, 0.f, 0.f, 0.f, 0.f, 0.f, 0.f, 0.f, 0.f, 0.f, 0.f, 0.f, 0.f, 0.f, 0.f};
    if (tiles == 0ull) return;
    u32x4 krA[KD / 64], vrA[DV / 64], krB[KD / 64], vrB[DV / 64];
    int Tlast;
    { const int T0 = __builtin_ctzll(tiles); Tlast = 63 - __builtin_clzll(tiles);
      stage_load_k<KD>(krA, Kg + (size_t)T0 * 64 * kpitch, kpitch, F.tid); stage_load_v<DV>(vrA, Vg + (size_t)T0 * 64 * vpitch, vpitch, wave, lane);
      stage_write_k<KD>(F.lds + A_KB, krA, F.tid); stage_write_v<DV>(F.lds + A_VB, vrA, wave, lane);
      const u64 t1 = tiles & (tiles - 1ull);
      const int T1 = t1 ? __builtin_ctzll(t1) : Tlast;
      stage_load_k<KD>(krA, Kg + (size_t)T1 * 64 * kpitch, kpitch, F.tid); stage_load_v<DV>(vrA, Vg + (size_t)T1 * 64 * vpitch, vpitch, wave, lane); }
    __syncthreads();
    const int voff = vtr_lane_off(lane);
    int cur = 0;
#define ATTN_STEP(RNk, RNv, RFk, RFv) { \
        const int Tt = __builtin_ctzll(tiles); tiles &= tiles - 1ull; \
        const bool more = tiles != 0ull; \
        { const u64 t2 = tiles & (tiles - 1ull); \
          const int T2 = t2 ? __builtin_ctzll(t2) : Tlast; \
          stage_load_k<KD>(RFk, Kg + (size_t)T2 * 64 * kpitch, kpitch, F.tid); stage_load_v<DV>(RFv, Vg + (size_t)T2 * 64 * vpitch, vpitch, wave, lane); } \
        f32x16 p0, p1; u32x4 pw[4]; \
        qk_tile<KD>(p0, p1, F.lds + A_KB + cur * 16384, kchunk0, r32, hi, qr, negm); \
        VFrag vf0; if (DV == 64) v_group_load(vf0, F.lds + A_VB + cur * 16384 + voff, 0);     \
        if (VAR == 2) { } else if (MODE == 1) { const u64 mk = ml[Tt * 32 + r32]; const int mlo = (int)((unsigned)mk >> (4 * hi)), mhi = (int)((unsigned)(mk >> 32) >> (4 * hi)); \
            _Pragma("unroll") for (int r = 0; r < 16; ++r) {     \
                const unsigned s0 = (unsigned)__builtin_amdgcn_sbfe(mlo, crow(r, 0), 1), s1 = (unsigned)__builtin_amdgcn_sbfe(mhi, crow(r, 0), 1); \
                p0[r] = __uint_as_float((__float_as_uint(p0[r]) & s0) | (0xff800000u & ~s0)); p1[r] = __uint_as_float((__float_as_uint(p1[r]) & s1) | (0xff800000u & ~s1)); } } \
        else { const int eff = ((rowsel >> Tt) & 1ull) ? kmax : -1; const int kv0 = 64 * Tt + 4 * hi; \
            if (__any(64 * Tt + 63 > eff)) { const int dd = eff - kv0; \
                _Pragma("unroll") for (int r = 0; r < 16; ++r) { p0[r] = (dd >= crow(r, 0)) ? p0[r] : -INFINITY; p1[r] = (dd >= crow(r, 0) + 32) ? p1[r] : -INFINITY; } } \
            if (__any(64 * Tt < kmin)) { const int dd = kmin - kv0; \
                _Pragma("unroll") for (int r = 0; r < 16; ++r) { p0[r] = (crow(r, 0) >= dd) ? p0[r] : -INFINITY; p1[r] = (crow(r, 0) + 32 >= dd) ? p1[r] : -INFINITY; } } } \
        softmax_tile<DV>(p0, p1, m, started, negm, l, o, wsf, r32, hi, pw); \
        if (DV != 64) v_group_load(vf0, F.lds + A_VB + cur * 16384 + voff, 0); \
        pv_tile<DV>(o, F.lds + A_VB + cur * 16384 + voff, pw, vf0); \
        stage_write_k<KD>(F.lds + A_KB + (cur ^ 1) * 16384, RNk, F.tid); stage_write_v<DV>(F.lds + A_VB + (cur ^ 1) * 16384, RNv, wave, lane); \
        __syncthreads(); cur ^= 1; \
        if (!more) break; }
    for (;;) {
        ATTN_STEP(krA, vrA, krB, vrB)
        ATTN_STEP(krB, vrB, krA, vrA)
    }
#undef ATTN_STEP
}

__device__ __forceinline__ void hs_glds16(const void* gsrc, unsigned lds_dst) { unsigned keep;
    asm volatile("s_mov_b32 %0, m0\n\ts_mov_b32 m0, %2\n\ts_nop 0\n\tglobal_load_lds_dwordx4 %1, off\n\ts_mov_b32 m0, %0" : "=&s"(keep) : "v"(gsrc), "s"(lds_dst) : "memory"); }

template <int MODE>
__device__ __forceinline__ void attn_dma_loop(const Frame& F, const u16* Kg, int kpitch, const u16* Vg, int vpitch, u64 tiles, int kmax, int kmin, u64 rowsel, const LAS u64* ml,
                                              const half8 (&qr)[4], f32x16 (&o)[2], float& m, float& l) {
    const int lane = F.lane, wave = F.wave, r32 = lane & 31, hi = lane >> 5;
    LAS float* wsf = (LAS float*)(F.lds + WSCR_OFF + wave * 1024);
    m = 0.f; l = 0.f; int started = 0;
    f32x16 negm = {0.f, 0.f, 0.f, 0.f, 0.f, 0.f, 0.f, 0.f, 0.f, 0.f, 0.f, 0.f, 0.f, 0.f, 0.f, 0.f};
    if (tiles == 0ull) return;
    constexpr int SL = 8192, VB = 3 * SL;
    const int lds0 = (int)(unsigned)(size_t)F.lds;
    const int krow = 8 * wave + (lane >> 3), kch = (lane & 7) ^ ((krow >> 1) & 7);
    const unsigned kso = (unsigned)(krow * kpitch + kch * 8) * 2u;
    const unsigned vso = (unsigned)((16 * (wave & 3) + (lane >> 2)) * vpitch + (wave >> 2) * 32 + (lane & 3) * 8) * 2u;
#define AD_DMA(T_, slot_) { hs_glds16((const char*)Kg + (size_t)(T_) * 128 * kpitch + kso, (unsigned)__builtin_amdgcn_readfirstlane(lds0 + (slot_) + wave * 1024)); \
                            hs_glds16((const char*)Vg + (size_t)(T_) * 128 * vpitch + vso, (unsigned)__builtin_amdgcn_readfirstlane(lds0 + VB + (slot_) + wave * 1024)); }
    int Tlast;
    { const int T0 = __builtin_ctzll(tiles); Tlast = 63 - __builtin_clzll(tiles);
      AD_DMA(T0, 0)
      const u64 t1 = tiles & (tiles - 1ull);
      const int T1 = t1 ? __builtin_ctzll(t1) : Tlast;
      AD_DMA(T1, SL) }
    asm volatile("s_waitcnt vmcnt(2) lgkmcnt(0)\n\ts_barrier" ::: "memory");
    const int voff = vtr_lane_off(lane);
    int sc = 0, sn2 = 2 * SL;
    for (;;) {
        sc = __builtin_amdgcn_readfirstlane(sc); sn2 = __builtin_amdgcn_readfirstlane(sn2);
        const int Tt = __builtin_ctzll(tiles); tiles &= tiles - 1ull;
        const bool more = tiles != 0ull;
        { const u64 t2 = tiles & (tiles - 1ull);
          const int T2 = t2 ? __builtin_ctzll(t2) : Tlast;
          AD_DMA(T2, sn2) }
        bool active = true;
        if (MODE == 0) active = __any(((rowsel >> Tt) & 1ull) != 0ull && kmax >= 64 * Tt && kmin <= 64 * Tt + 63);
        if (active) {
        f32x16 p0, p1; u32x4 pw[4];
        qk_tile<64>(p0, p1, F.lds + sc, 0, r32, hi, qr, negm);
        VFrag vf0; v_group_load(vf0, F.lds + VB + sc + voff, 0);
        if (MODE == 1) { const u64 mk = ml[Tt * 32 + r32]; const int mlo = (int)((unsigned)mk >> (4 * hi)), mhi = (int)((unsigned)(mk >> 32) >> (4 * hi));
#pragma unroll
            for (int r = 0; r < 16; ++r) {
                const unsigned s0 = (unsigned)__builtin_amdgcn_sbfe(mlo, crow(r, 0), 1), s1 = (unsigned)__builtin_amdgcn_sbfe(mhi, crow(r, 0), 1);
                p0[r] = __uint_as_float((__float_as_uint(p0[r]) & s0) | (0xff800000u & ~s0)); p1[r] = __uint_as_float((__float_as_uint(p1[r]) & s1) | (0xff800000u & ~s1)); } }
        else { const int eff = ((rowsel >> Tt) & 1ull) ? kmax : -1; const int kv0 = 64 * Tt + 4 * hi;
            if (__any(64 * Tt + 63 > eff)) { const int dd = eff - kv0;
#pragma unroll
                for (int r = 0; r < 16; ++r) { p0[r] = (dd >= crow(r, 0)) ? p0[r] : -INFINITY; p1[r] = (dd >= crow(r, 0) + 32) ? p1[r] : -INFINITY; } }
            if (__any(64 * Tt < kmin)) { const int dd = kmin - kv0;
#pragma unroll
                for (int r = 0; r < 16; ++r) { p0[r] = (crow(r, 0) >= dd) ? p0[r] : -INFINITY; p1[r] = (crow(r, 0) + 32 >= dd) ? p1[r] : -INFINITY; } } }
        softmax_tile<64>(p0, p1, m, started, negm, l, o, wsf, r32, hi, pw);
        pv_tile<64>(o, F.lds + VB + sc + voff, pw, vf0);
        }
        asm volatile("s_waitcnt vmcnt(2) lgkmcnt(0)\n\ts_barrier" ::: "memory");
        sn2 = sc; sc = (sc == 2 * SL) ? 0 : sc + SL;
        if (!more) break;
    }
    asm volatile("s_waitcnt vmcnt(0)" ::: "memory");
    __syncthreads();
#undef AD_DMA
}

#define HS_SBAR() __builtin_amdgcn_sched_barrier(0)
#define HS_PIN(x) asm volatile("" : "+v"(x))
#define HS_WAIT_BAR(N) asm volatile("s_waitcnt vmcnt(" #N ") lgkmcnt(0)\n\ts_barrier" ::: "memory")
struct HsVf { v4i16 lo, hh; };
__device__ __forceinline__ void diff_loop_hs(const Frame& F, const u16* Kg, const u16* Vg, int NT, int tq, int chunk0, const half8 (&qr)[4], f32x16 (&o)[4], float& l_out, bool first, int NTn) {
    const int lane = F.lane, wave = F.wave, r32 = lane & 31, hi = lane >> 5;
    LAS float* wsf = (LAS float*)(F.lds + WSCR_OFF + wave * 1024);
    constexpr int SLOT = 16384, VB = 3 * SLOT;
    constexpr size_t TSTEP = (size_t)64 * ODD_N * 2;
    unsigned kso[2], vso[2];
#pragma unroll
    for (int i = 0; i < 2; ++i) { const int p = wave + 8 * i, row = 4 * p + (lane >> 4), c = (lane & 15) ^ (row & 15); kso[i] = (unsigned)(row * ODD_N + c * 8) * 2u; }
#pragma unroll
    for (int i = 0; i < 2; ++i) { const int p = wave + 8 * i, dh = p >> 2, rg = p & 3; vso[i] = (unsigned)((16 * rg + (lane >> 2)) * ODD_N + dh * 32 + (lane & 3) * 8) * 2u; }
#define HS_DMA_KN(t_, slot_, nt_) { const int tt_ = ((t_) < (nt_)) ? (t_) : (nt_) - 1; const char* g_ = (const char*)Kg + (size_t)tt_ * TSTEP; \
        _Pragma("unroll") for (int i_ = 0; i_ < 2; ++i_) hs_glds16(g_ + kso[i_], (unsigned)__builtin_amdgcn_readfirstlane(lds0 + (slot_) + (wave + 8 * i_) * 1024)); }
#define HS_DMA_VN(t_, slot_, nt_) { const int tt_ = ((t_) < (nt_)) ? (t_) : (nt_) - 1; const char* g_ = (const char*)Vg + (size_t)tt_ * TSTEP; \
        _Pragma("unroll") for (int i_ = 0; i_ < 2; ++i_) hs_glds16(g_ + vso[i_], (unsigned)__builtin_amdgcn_readfirstlane(lds0 + VB + (slot_) + (wave + 8 * i_) * 1024)); }
#define HS_DMA_K(t_, slot_) HS_DMA_KN(t_, slot_, NT)
#define HS_DMA_V(t_, slot_) HS_DMA_VN(t_, slot_, NT)
    const int lds0 = (int)(unsigned)(size_t)F.lds;
    int kfo[4];
#pragma unroll
    for (int d0 = 0; d0 < 4; ++d0) kfo[d0] = r32 * 256 + (((chunk0 + 2 * d0 + hi) ^ (r32 & 15)) * 16);
    const int voff = vtr_lane_off(lane);
    if (first) { HS_DMA_K(0, 0) HS_DMA_V(0, 0) HS_DMA_K(1, SLOT) HS_DMA_K(2, 2 * SLOT) }
    f32x16 negm = {0.f, 0.f, 0.f, 0.f, 0.f, 0.f, 0.f, 0.f, 0.f, 0.f, 0.f, 0.f, 0.f, 0.f, 0.f, 0.f};
    f32x16 P[2]; half8 kf[8]; u32x4 pw[4]; HsVf vf[4];
    float m = 0.f, l = 0.f; bool resc = false;
#define HS_KLD(j_, slot_) kf[j_] = *(const LAS half8*)(F.lds + (slot_) + kfo[(j_) >> 1] + ((j_) & 1) * 8192)
#define HS_MASK(t_) { const int dd_ = tq - (64 * (t_) + 4 * hi); \
        _Pragma("unroll") for (int r = 0; r < 16; ++r) { P[0][r] = (dd_ >= crow(r, 0)) ? P[0][r] : -INFINITY; P[1][r] = (dd_ >= crow(r, 0) + 32) ? P[1][r] : -INFINITY; } }
#define HS_MX3(a, b, c) __builtin_fmaxf(__builtin_fmaxf((a), (b)), (c))
#define HS_ROWMAX(rm_) { float a_ = HS_MX3(P[0][0], P[0][1], P[1][0]), b_ = HS_MX3(P[0][2], P[0][3], P[1][1]); a_ = HS_MX3(a_, P[1][2], P[1][3]); \
        _Pragma("unroll") for (int r = 4; r < 16; r += 4) { a_ = HS_MX3(a_, P[0][r], P[0][r + 1]); b_ = HS_MX3(b_, P[0][r + 2], P[0][r + 3]); a_ = HS_MX3(a_, P[1][r], P[1][r + 1]); b_ = HS_MX3(b_, P[1][r + 2], P[1][r + 3]); } \
        rm_ = swap_max(__builtin_fmaxf(a_, b_)); }
#define HS_PE(e_) P[(e_) >> 4][(e_) & 15]
    if (first) HS_WAIT_BAR(6);
    else HS_WAIT_BAR(0);
#pragma unroll
    for (int j = 0; j < 8; ++j) HS_KLD(j, 0);
#pragma unroll
    for (int d0 = 0; d0 < 4; ++d0) {
        P[0] = __builtin_amdgcn_mfma_f32_32x32x16_f16(kf[2 * d0], qr[d0], d0 ? P[0] : negm, 0, 0, 0);
        P[1] = __builtin_amdgcn_mfma_f32_32x32x16_f16(kf[2 * d0 + 1], qr[d0], d0 ? P[1] : negm, 0, 0, 0); }
    if (NT == 2) HS_MASK(0)
    { float rm; HS_ROWMAX(rm) m = rm;
#pragma unroll
      for (int r = 0; r < 16; ++r) { P[0][r] -= rm; P[1][r] -= rm; negm[r] = -m; }
      float sacc = 0.f;
#pragma unroll
      for (int e = 0; e < 32; ++e) { HS_PE(e) = __builtin_amdgcn_exp2f(HS_PE(e)); sacc += HS_PE(e); }
      l = sacc;
#pragma unroll
      for (int c = 0; c < 16; ++c) pw[c >> 2][c & 3] = pkh(HS_PE(2 * c), HS_PE(2 * c + 1)); }
    HS_WAIT_BAR(2);
    HS_DMA_K(3, 0) HS_DMA_V(1, SLOT)
#pragma unroll
    for (int j = 0; j < 8; ++j) HS_KLD(j, SLOT);
#pragma unroll
    for (int d0 = 0; d0 < 4; ++d0) {
        P[0] = __builtin_amdgcn_mfma_f32_32x32x16_f16(kf[2 * d0], qr[d0], d0 ? P[0] : negm, 0, 0, 0);
        P[1] = __builtin_amdgcn_mfma_f32_32x32x16_f16(kf[2 * d0 + 1], qr[d0], d0 ? P[1] : negm, 0, 0, 0); }
    HS_WAIT_BAR(4);
    int sp = 0, sc = SLOT, sn = 2 * SLOT;
    for (int t = 1; t < NT; ++t) {
        const bool last = (t == NT - 1);
        sp = __builtin_amdgcn_readfirstlane(sp); sc = __builtin_amdgcn_readfirstlane(sc); sn = __builtin_amdgcn_readfirstlane(sn);
        HS_SBAR();
        HS_DMA_K(t + 3, sc) HS_DMA_V(t + 1, sn)
        const LAS unsigned char* vb = F.lds + VB + sp + voff;
#pragma unroll
        for (int d0 = 0; d0 < 4; ++d0) { vf[d0].lo = vtr(vb + d0 * 4096); vf[d0].hh = vtr(vb + d0 * 4096 + 512); }
        HS_SBAR();
        if (t >= NT - 2) HS_MASK(t)
        { float rm; HS_ROWMAX(rm)
          resc = false;
          if (__builtin_expect(__any(rm > 8.0f), 0)) {
              const float dl = __builtin_fmaxf(rm, 0.f); m += dl;
#pragma unroll
              for (int r = 0; r < 16; ++r) { P[0][r] -= dl; P[1][r] -= dl; negm[r] = -m; }
              HS_PIN(negm);
              const float f = __builtin_amdgcn_exp2f(-dl); l *= f; if (hi == 0) wsf[r32] = f; resc = true; } }
        HS_SBAR();
        float sacc = 0.f;
#pragma unroll
        for (int g = 0; g < 16; ++g) {
            const int ks = g >> 2, d0 = g & 3;
            { const s16x8 vfr = {vf[d0].lo[0], vf[d0].lo[1], vf[d0].lo[2], vf[d0].lo[3], vf[d0].hh[0], vf[d0].hh[1], vf[d0].hh[2], vf[d0].hh[3]};
              o[d0] = __builtin_amdgcn_mfma_f32_32x32x16_f16(__builtin_bit_cast(half8, pw[ks]), __builtin_bit_cast(half8, vfr), o[d0], 0, 0, 0); }
            if (g + 4 < 16) { const int ks2 = (g + 4) >> 2; vf[d0].lo = vtr(vb + d0 * 4096 + ks2 * 1024); vf[d0].hh = vtr(vb + d0 * 4096 + ks2 * 1024 + 512); }
            if (!last && g >= 4 && g < 12) { const int q_ = g - 4; const int j = (q_ == 0) ? 0 : (q_ == 1) ? 2 : (q_ == 2) ? 1 : (q_ == 3) ? 4 : (q_ == 4) ? 3 : (q_ == 5) ? 6 : (q_ == 6) ? 5 : 7; HS_KLD(j, sn); }
            HS_PE(2 * g) = __builtin_amdgcn_exp2f(HS_PE(2 * g)); HS_PE(2 * g + 1) = __builtin_amdgcn_exp2f(HS_PE(2 * g + 1));
            if (g >= 1) { sacc += HS_PE(2 * g - 2); sacc += HS_PE(2 * g - 1); HS_PIN(sacc); }
            if (g >= 4) { const int c = g - 4; pw[c >> 2][c & 3] = pkh(HS_PE(2 * c), HS_PE(2 * c + 1)); HS_PIN(pw[c >> 2]); }
            HS_PIN(P[0]); HS_PIN(P[1]);
            HS_SBAR();
        }
        if (!last) {
            P[0] = __builtin_amdgcn_mfma_f32_32x32x16_f16(kf[0], qr[0], negm, 0, 0, 0);
            sacc += P[1][14]; sacc += P[1][15]; pw[3][0] = pkh(P[1][8], P[1][9]); pw[3][1] = pkh(P[1][10], P[1][11]); HS_PIN(sacc); HS_PIN(pw[3]); HS_SBAR();
            P[0] = __builtin_amdgcn_mfma_f32_32x32x16_f16(kf[2], qr[1], P[0], 0, 0, 0);
            pw[3][2] = pkh(P[1][12], P[1][13]); pw[3][3] = pkh(P[1][14], P[1][15]); HS_PIN(pw[3]); HS_SBAR();
            P[1] = __builtin_amdgcn_mfma_f32_32x32x16_f16(kf[1], qr[0], negm, 0, 0, 0); HS_SBAR();
            P[0] = __builtin_amdgcn_mfma_f32_32x32x16_f16(kf[4], qr[2], P[0], 0, 0, 0); HS_SBAR();
            P[1] = __builtin_amdgcn_mfma_f32_32x32x16_f16(kf[3], qr[1], P[1], 0, 0, 0); HS_SBAR();
            P[0] = __builtin_amdgcn_mfma_f32_32x32x16_f16(kf[6], qr[3], P[0], 0, 0, 0); HS_SBAR();
            P[1] = __builtin_amdgcn_mfma_f32_32x32x16_f16(kf[5], qr[2], P[1], 0, 0, 0); HS_SBAR();
            P[1] = __builtin_amdgcn_mfma_f32_32x32x16_f16(kf[7], qr[3], P[1], 0, 0, 0); HS_SBAR();
            l += sacc;
            HS_WAIT_BAR(4);
        } else {
            sacc += P[1][14]; sacc += P[1][15]; l += sacc;
            pw[3] = (u32x4){pkh(P[1][8], P[1][9]), pkh(P[1][10], P[1][11]), pkh(P[1][12], P[1][13]), pkh(P[1][14], P[1][15])};
            HS_WAIT_BAR(0);
        }
        if (resc) {
            asm volatile("s_waitcnt lgkmcnt(0)" ::: "memory");
#pragma unroll
            for (int r = 0; r < 16; ++r) { const float fr_ = wsf[crow(r, hi)];
#pragma unroll
                for (int d0 = 0; d0 < 4; ++d0) o[d0][r] *= fr_; } }
        { const int s_ = sp; sp = sc; sc = sn; sn = s_; }
    }
    { const LAS unsigned char* vb = F.lds + VB + sp + voff;
#pragma unroll
      for (int d0 = 0; d0 < 4; ++d0) { vf[d0].lo = vtr(vb + d0 * 4096); vf[d0].hh = vtr(vb + d0 * 4096 + 512); }
#pragma unroll
      for (int g = 0; g < 16; ++g) {
          const int ks = g >> 2, d0 = g & 3;
          { const s16x8 vfr = {vf[d0].lo[0], vf[d0].lo[1], vf[d0].lo[2], vf[d0].lo[3], vf[d0].hh[0], vf[d0].hh[1], vf[d0].hh[2], vf[d0].hh[3]};
            o[d0] = __builtin_amdgcn_mfma_f32_32x32x16_f16(__builtin_bit_cast(half8, pw[ks]), __builtin_bit_cast(half8, vfr), o[d0], 0, 0, 0); }
          if (g + 4 < 16) { const int ks2 = (g + 4) >> 2; vf[d0].lo = vtr(vb + d0 * 4096 + ks2 * 1024); vf[d0].hh = vtr(vb + d0 * 4096 + ks2 * 1024 + 512); }
          HS_SBAR(); } }
    l_out = l;
    asm volatile("s_waitcnt lgkmcnt(0)\n\ts_barrier" ::: "memory");
    if (NTn) { HS_DMA_KN(0, 0, NTn) HS_DMA_VN(0, 0, NTn) HS_DMA_KN(1, SLOT, NTn) HS_DMA_KN(2, 2 * SLOT, NTn) }
#undef HS_DMA_K
#undef HS_DMA_V
#undef HS_DMA_KN
#undef HS_DMA_VN
#undef HS_KLD
#undef HS_MASK
#undef HS_MX3
#undef HS_ROWMAX
#undef HS_PE
}

template <int DV> __device__ __forceinline__ void flush_stage(const LAS u16* stg, u16* Og, int lane) {
    asm volatile("s_waitcnt lgkmcnt(0)" ::: "memory");
    constexpr int CPR = DV / 8, RPI = 64 / CPR;
#pragma unroll
    for (int i = 0; i < 32 / RPI; ++i) { const int row = i * RPI + lane / CPR, ch = lane % CPR;
        const u32x4 v = *(const LAS u32x4*)(stg + row * DV + ch * 8);
        *(GAS u32x4*)(Og + (size_t)row * DM + ch * 8) = v;
        if (DV == 128 && (i & 1)) asm volatile("" ::: "memory"); }
}


#ifndef PROBE_VAR
#define PROBE_VAR -1
#endif
template <int VAR> __device__ __forceinline__ void dsa_probe_unit(const Frame& F, int b, int qb) {
    const int lane = F.lane, wave = F.wave, r32 = lane & 31, hi = lane >> 5;
    unsigned char* ws = F.ws;
    const u16* Pb = (const u16*)(ws + WS_P) + (size_t)b * T * EVEN_N;
    const u64* MASK = (const u64*)(ws + WS_MASK);
    u16* O = (u16*)(ws + 224 * MiB);
    const int t0 = qb * 32, NT = ((t0 + 31) >> 6) + 1;
    LAS u64* ml = (LAS u64*)(F.lds + A_AUX);
    LAS float* wsf = (LAS float*)(F.lds + WSCR_OFF + wave * 1024);
    for (int i = F.tid; i < NT * 32; i += 512) { const int q = i & 31, tl = i >> 5; ml[tl * 32 + q] = ((const GAS u64*)MASK)[(size_t)(b * T + t0 + q) * 64 + tl]; }
    half8 qr[4];
    { const u16* qp = Pb + (size_t)(t0 + r32) * EVEN_N + C_QA + wave * 64 + hi * 8;
#pragma unroll
      for (int d0 = 0; d0 < 4; ++d0) qr[d0] = *(const GAS half8*)(qp + d0 * 16); }
    f32x16 o[2]; float m = 0.f, l = 0.f;
#pragma unroll
    for (int d0 = 0; d0 < 2; ++d0)
#pragma unroll
        for (int r = 0; r < 16; ++r) o[d0][r] = 0.f;
    const u64 tiles = (NT >= 64) ? ~0ull : ((1ull << NT) - 1ull);
    attn_range_loop<64, 64, 1, VAR>(F, Pb + C_KA, EVEN_N, 0, Pb + C_VA, EVEN_N, tiles, 0, 0, ~0ull, ml, qr, o, m, l);
    __syncthreads();
    float rli[16]; finalize_rows(l, 1.0f, wsf, r32, hi, rli);
    LAS u16* stg = (LAS u16*)(F.lds + A_AUX + 32768 + wave * 4096);
#pragma unroll
    for (int r = 0; r < 16; ++r)
#pragma unroll
        for (int d0 = 0; d0 < 2; ++d0) stg[crow(r, hi) * 64 + d0 * 32 + r32] = (u16)(pkh(o[d0][r] * rli[r], 0.f) & 0xffffu);
    flush_stage<64>(stg, O + (size_t)(b * T + t0) * DM + wave * 64, lane);
    __syncthreads();
}

__device__ __forceinline__ void dsa_unit(const Frame& F, int b, int qb) {
    const int lane = F.lane, wave = F.wave, r32 = lane & 31, hi = lane >> 5;
    unsigned char* ws = F.ws;
    const u16* Pb = (const u16*)(ws + WS_P) + (size_t)b * T * EVEN_N;
    const u64* MASK = (const u64*)(ws + WS_MASK);
    u16* O = (u16*)(ws + WS_O16);
    const int t0 = qb * 32, NT = ((t0 + 31) >> 6) + 1;
    LAS u64* ml = (LAS u64*)(F.lds + A_AUX);
    LAS float* wsf = (LAS float*)(F.lds + WSCR_OFF + wave * 1024);
    for (int i = F.tid; i < NT * 32; i += 512) { const int q = i & 31, tl = i >> 5; ml[tl * 32 + q] = ((const GAS u64*)MASK)[(size_t)(b * T + t0 + q) * 64 + tl]; }
    half8 qr[4];
    { const u16* qp = Pb + (size_t)(t0 + r32) * EVEN_N + C_QA + wave * 64 + hi * 8;
#pragma unroll
      for (int d0 = 0; d0 < 4; ++d0) qr[d0] = *(const GAS half8*)(qp + d0 * 16); }
    f32x16 o[2]; float m = NEG_BIG, l = 0.f;
#pragma unroll
    for (int d0 = 0; d0 < 2; ++d0)
#pragma unroll
        for (int r = 0; r < 16; ++r) o[d0][r] = 0.f;
    const u64 tiles = (NT >= 64) ? ~0ull : ((1ull << NT) - 1ull);
    attn_dma_loop<1>(F, Pb + C_KA, EVEN_N, Pb + C_VA, EVEN_N, tiles, 0, 0, ~0ull, ml, qr, o, m, l);
    float rli[16]; finalize_rows(l, 1.0f, wsf, r32, hi, rli);
    LAS u16* stg = (LAS u16*)(F.lds + A_AUX + 32768 + wave * 4096);
#pragma unroll
    for (int r = 0; r < 16; ++r)
#pragma unroll
        for (int d0 = 0; d0 < 2; ++d0) stg[crow(r, hi) * 64 + d0 * 32 + r32] = (u16)(pkh(o[d0][r] * rli[r], 0.f) & 0xffffu);
    flush_stage<64>(stg, O + (size_t)(b * T + t0) * DM + wave * 64, lane);
}


typedef float f32x4v __attribute__((ext_vector_type(4)));
__device__ __forceinline__ void dsa_sparse_wave(const Frame& F, int early, int bfix, int ifix, int klo, int gw, int nw) {
    int lane = F.lane; asm volatile("" : "+v"(lane));
    const int wave = F.wave, n16 = lane & 15, g4 = lane >> 4;
    unsigned char* ws = F.ws;
    const u16* Pall = (const u16*)(ws + WS_P);
    const GAS u64* MASKall = (const GAS u64*)(ws + WS_MASK);
    u16* O = (u16*)(ws + WS_O16);
    LAS float* wsf = (LAS float*)(F.lds + WSCR_OFF + wave * 1024);
    LAS u16* listA = (LAS u16*)(F.lds + WSCR_OFF + wave * 1024 + 512);
    LAS u16* listB = (LAS u16*)(F.lds + LDSCTL_OFF + 1024 + wave * 512);
    const int kslot = wave * 16384, vslot = wave * 16384 + 8192;
    const int lds0 = (int)(unsigned)(size_t)F.lds;
    const int krl = lane >> 3;
    const int nq = early ? ((gw < 8192) ? (8192 - gw + nw - 1) / nw : 0) : 8 - klo;
    if (nq <= 0) return;
#define SP_Q(j_, row_, t_) { if (early) { const int e_ = gw + nw * (j_); t_ = 64 * (8 * (e_ & 3) + ((e_ >> 2) & 7)) + ((e_ >> 5) & 63); row_ = (e_ >> 11) * T + t_; } \
                             else { t_ = 64 * (8 * (klo + (j_)) + wave) + ifix; row_ = bfix * T + t_; } }
#define SP_DMA_K(L_, tt_, PB_) { const int tb_ = 64 * (tt_); int key_[8]; \
        _Pragma("unroll") for (int p_ = 0; p_ < 8; ++p_) key_[p_] = (L_)[tb_ + 8 * p_ + krl];              \
        _Pragma("unroll") for (int p_ = 0; p_ < 8; ++p_) { const int row_ = 8 * p_ + krl; const int ch_ = (lane & 7) ^ ((row_ >> 1) & 7); \
            hs_glds16((const char*)((PB_) + C_KA) + ((size_t)key_[p_] * EVEN_N + ch_ * 8) * 2, (unsigned)__builtin_amdgcn_readfirstlane(lds0 + kslot + p_ * 1024)); } }
#define SP_DMA_V(L_, tt_, PB_) { const int tb_ = 64 * (tt_); int key_[8]; \
        _Pragma("unroll") for (int p_ = 0; p_ < 8; ++p_) key_[p_] = (L_)[tb_ + 8 * p_ + krl]; \
        _Pragma("unroll") for (int p_ = 0; p_ < 8; ++p_) { const int row_ = 8 * p_ + krl; const int ch_ = ((((lane & 7) >> 1) ^ ((row_ >> 1) & 3)) << 1) | (lane & 1); \
            hs_glds16((const char*)((PB_) + C_VA) + ((size_t)key_[p_] * EVEN_N + ch_ * 8) * 2, (unsigned)__builtin_amdgcn_readfirstlane(lds0 + vslot + p_ * 1024)); } }
#define SP_BUILD(w_, L_, n_, tq_) { ((LAS u64*)(L_))[lane] = (w_); n_ = ((tq_) + 1 < 256) ? (tq_) + 1 : 256; asm volatile("s_waitcnt lgkmcnt(0)" ::: "memory"); }
#define SP_QLOAD(row_) { const u16* qp_ = Pall + (size_t)(row_) * EVEN_N + C_QA + (n16 & 7) * 64 + g4 * 8; \
        qr[0] = *(const GAS half8*)(qp_); qr[1] = *(const GAS half8*)(qp_ + 32); }
    half8 qr[2];
    int n_cur, n_nxt = 0, row_c, t_c, row_n = 0, t_n = 0;
    u64 wn = 0ull;
    { SP_Q(0, row_c, t_c)
      const u64 w0 = MASKall[(size_t)row_c * 64 + lane];
      if (nq > 1) { SP_Q(1, row_n, t_n) wn = MASKall[(size_t)row_n * 64 + lane]; }
      SP_QLOAD(row_c)
      SP_BUILD(w0, listA, n_cur, t_c)
      const u16* Pb0 = Pall + (size_t)(row_c - t_c) * EVEN_N;
      SP_DMA_K(listA, 0, Pb0) SP_DMA_V(listA, 0, Pb0) }
    for (int k = 0; k < nq; ++k) {
        LAS u16* list = (k & 1) ? listB : listA;
        LAS u16* lnext = (k & 1) ? listA : listB;
        const int n = n_cur, NTq = (n + 63) >> 6;
        const bool hasn = (k + 1 < nq);
        const u16* Pb = Pall + (size_t)(row_c - t_c) * EVEN_N;
        const u16* Pbn = Pall + (size_t)(row_n - t_n) * EVEN_N;
        if (hasn) SP_BUILD(wn, lnext, n_nxt, t_n)
        f32x4v o[4]; float m = 0.f, l = 0.f; bool started = false;
        f32x4v negm = {0.f, 0.f, 0.f, 0.f};
#pragma unroll
        for (int nb = 0; nb < 4; ++nb) o[nb] = (f32x4v){0.f, 0.f, 0.f, 0.f};
        for (int tl = 0; tl < NTq; ++tl) {
            const bool lastt = (tl + 1 == NTq), more = !lastt || hasn;
            asm volatile("s_waitcnt vmcnt(8)" ::: "memory");
            f32x4v s[4];
            { half8 kf[4][2];
#pragma unroll
              for (int blk = 0; blk < 4; ++blk) { const int row = 16 * blk + n16; const LAS unsigned char* kb = F.lds + kslot + row * 128;
#pragma unroll
                  for (int c = 0; c < 2; ++c) kf[blk][c] = *(const LAS half8*)(kb + kswz<64>(row, 4 * c + g4) * 16); }
              __builtin_amdgcn_sched_barrier(0);
#pragma unroll
              for (int blk = 0; blk < 4; ++blk) {
                  s[blk] = __builtin_amdgcn_mfma_f32_16x16x32_f16(kf[blk][0], qr[0], negm, 0, 0, 0);
                  s[blk] = __builtin_amdgcn_mfma_f32_16x16x32_f16(kf[blk][1], qr[1], s[blk], 0, 0, 0); } }
            asm volatile("s_waitcnt lgkmcnt(0)" ::: "memory");
            if (!lastt) { SP_DMA_K(list, tl + 1, Pb) } else if (hasn) { SP_DMA_K(lnext, 0, Pbn) }
            if (64 * tl + 63 >= n) { const int kp = 64 * tl + 4 * g4;
#pragma unroll
                for (int blk = 0; blk < 4; ++blk)
#pragma unroll
                    for (int r = 0; r < 4; ++r) s[blk][r] = (kp + 16 * blk + r < n) ? s[blk][r] : -INFINITY; }
            float mx = fmaxf(fmaxf(s[0][0], s[0][1]), fmaxf(s[0][2], s[0][3]));
#pragma unroll
            for (int blk = 1; blk < 4; ++blk) mx = fmaxf(mx, fmaxf(fmaxf(s[blk][0], s[blk][1]), fmaxf(s[blk][2], s[blk][3])));
            bool move = !started;
            if (started) move = __any(mx > 8.0f);
            if (move) {
                float rm = fmaxf(mx, __shfl_xor(mx, 16)); rm = fmaxf(rm, __shfl_xor(rm, 32));
                const float dl = started ? fmaxf(rm, 0.f) : rm;
                m += dl;
#pragma unroll
                for (int blk = 0; blk < 4; ++blk)
#pragma unroll
                    for (int r = 0; r < 4; ++r) s[blk][r] -= dl;
                negm = (f32x4v){-m, -m, -m, -m};
                const float f = started ? __builtin_amdgcn_exp2f(-dl) : 1.f;
                l *= f;
                if (started) {
                    if (lane < 16) wsf[lane] = f;
                    asm volatile("s_waitcnt lgkmcnt(0)" ::: "memory");
#pragma unroll
                    for (int r = 0; r < 4; ++r) { const float fr_ = wsf[4 * g4 + r];
#pragma unroll
                        for (int nb = 0; nb < 4; ++nb) o[nb][r] *= fr_; }
                    asm volatile("s_waitcnt lgkmcnt(0)" ::: "memory"); }
                started = true; }
            u32x4 pw[2];
#pragma unroll
            for (int blk = 0; blk < 4; ++blk) {
#pragma unroll
                for (int r = 0; r < 4; ++r) { s[blk][r] = __builtin_amdgcn_exp2f(s[blk][r]); l += s[blk][r]; } }
            pw[0] = (u32x4){pkh(s[0][0], s[0][1]), pkh(s[0][2], s[0][3]), pkh(s[1][0], s[1][1]), pkh(s[1][2], s[1][3])};
            pw[1] = (u32x4){pkh(s[2][0], s[2][1]), pkh(s[2][2], s[2][3]), pkh(s[3][0], s[3][1]), pkh(s[3][2], s[3][3])};
            if (more) asm volatile("s_waitcnt vmcnt(8)" ::: "memory"); else asm volatile("s_waitcnt vmcnt(0)" ::: "memory");
            { const int q_ = n16 >> 2, sw_ = (2 * g4 + (q_ >> 1)) & 3;
              const LAS unsigned char* vb = F.lds + vslot + (4 * g4 + q_) * 128 + (n16 & 3) * 8;
#pragma unroll
              for (int nb = 0; nb < 4; ++nb) {
                  const LAS unsigned char* vn = vb + ((nb ^ sw_) * 32);
                  v4i16 va[2][2];
#pragma unroll
                  for (int kc = 0; kc < 2; ++kc) { va[kc][0] = vtr(vn + kc * 4096); va[kc][1] = vtr(vn + kc * 4096 + 2048); }
#pragma unroll
                  for (int kc = 0; kc < 2; ++kc) {
                      const s16x8 vf = {va[kc][0][0], va[kc][0][1], va[kc][0][2], va[kc][0][3], va[kc][1][0], va[kc][1][1], va[kc][1][2], va[kc][1][3]};
                      o[nb] = __builtin_amdgcn_mfma_f32_16x16x32_f16(__builtin_bit_cast(half8, pw[kc]), __builtin_bit_cast(half8, vf), o[nb], 0, 0, 0); } } }
            asm volatile("s_waitcnt lgkmcnt(0)" ::: "memory");
            if (!lastt) { SP_DMA_V(list, tl + 1, Pb) } else if (hasn) { SP_DMA_V(lnext, 0, Pbn) }
        }
        const int row_o = row_c;
        if (hasn) { row_c = row_n; t_c = t_n; SP_QLOAD(row_c) }
        if (k + 2 < nq) { SP_Q(k + 2, row_n, t_n) wn = MASKall[(size_t)row_n * 64 + lane]; }
        { float L = l + __shfl_xor(l, 16); L += __shfl_xor(L, 32);
          if (lane < 16) wsf[32 + lane] = 1.0f / fmaxf(L, 1e-30f);
          asm volatile("s_waitcnt lgkmcnt(0)" ::: "memory");
          GAS u16* Ob = (GAS u16*)O + (size_t)row_o * DM + n16;
          if (g4 < 2) {
#pragma unroll
              for (int r = 0; r < 4; ++r) { const float rl = wsf[32 + 4 * g4 + r];
#pragma unroll
                  for (int nb = 0; nb < 4; ++nb) Ob[(4 * g4 + r) * 64 + nb * 16] = (u16)(pkh(o[nb][r] * rl, 0.f) & 0xffffu); } }
          asm volatile("s_waitcnt lgkmcnt(0)" ::: "memory"); }
        n_cur = n_nxt;
    }
#undef SP_Q
#undef SP_DMA_K
#undef SP_DMA_V
#undef SP_BUILD
#undef SP_QLOAD
}

__device__ __forceinline__ float sigmoidf_(float x) { return 1.0f / (1.0f + __expf(-x)); }
__device__ __forceinline__ u64 wave_or64(u64 v) {
    unsigned lo = (unsigned)v, hh = (unsigned)(v >> 32);
#pragma unroll
    for (int o = 1; o < 64; o <<= 1) { lo |= __shfl_xor(lo, o); hh |= __shfl_xor(hh, o); }
    return ((u64)hh << 32) | lo;
}

__device__ __forceinline__ void nsa_unit(const Frame& F, int b, int g, int qb) {
    const int lane = F.lane, wave = F.wave, r32 = lane & 31, hi = lane >> 5;
    const int j = wave & 3, qs = wave >> 2, hb = g * 4 + j;
    unsigned char* ws = F.ws;
    const u16* Pb = (const u16*)(ws + WS_P) + (size_t)b * T * EVEN_N;
    const u16* KVC = (const u16*)(ws + WS_KVC);
    u16* O = (u16*)(ws + WS_O16);
    const int t0 = qb * 64, tq = t0 + 32 * qs + r32, cur = qb;
    LAS float* wsf = (LAS float*)(F.lds + WSCR_OFF + wave * 1024);
    LAS unsigned* imp = (LAS unsigned*)(F.lds + A_AUX);
    LAS u64* selm = (LAS u64*)(F.lds + A_AUX + 16896);
    for (int i = F.tid; i < 64 * 65; i += 512) imp[i] = 0u;
    const GAS u16* prow = (const GAS u16*)Pb + (size_t)tq * EVEN_N;
    half8 qr[4];
#pragma unroll
    for (int d0 = 0; d0 < 4; ++d0) qr[d0] = *(const GAS half8*)(prow + C_QB + hb * 64 + hi * 8 + d0 * 16);
    const float g0 = sigmoidf_(h2f(prow[C_GB + hb * 3 + 0])), g1 = sigmoidf_(h2f(prow[C_GB + hb * 3 + 1])), g2 = sigmoidf_(h2f(prow[C_GB + hb * 3 + 2]));
    unsigned oacc[2][8]; f32x16 o[2]; float m, l, rli[16];
#pragma unroll
    for (int d0 = 0; d0 < 2; ++d0)
#pragma unroll
        for (int r = 0; r < 8; ++r) oacc[d0][r] = 0u;
    const u16* kc = KVC + (size_t)((0 * 4 + b) * 2 + g) * 256 * 256;
    const u16* vc = KVC + (size_t)((1 * 4 + b) * 2 + g) * 256 * 256;
    const int ncmp = (tq >= 31) ? ((tq - 31) >> 4) : -1;
    const int ntc = ((t0 + 32) >> 10) + 1;
    u64 mysel = ~0ull, uni = 0ull;
    for (int br = 0; br < 3; ++br) {
        const u16* Kg; const u16* Vg; int pitch, kmax, kmin; u64 tiles, rsel; float gate;
        if (br == 0) { Kg = kc; Vg = vc; pitch = 256; kmax = ncmp; kmin = -(1 << 30); tiles = (1ull << ntc) - 1ull; rsel = ~0ull; gate = g0; }
        else if (br == 1) { Kg = Pb + C_KS + g * 64; Vg = Pb + C_VS + g * 64; pitch = EVEN_N; kmax = tq; kmin = -(1 << 30); tiles = uni; rsel = mysel; gate = g1; }
        else { Kg = Pb + (g ? C_KW1 : C_KW0); Vg = Pb + C_VW + g * 64; pitch = EVEN_N; kmax = tq; kmin = tq - 511; rsel = ~0ull; gate = g2;
               const int tlo = (cur - 8 > 0) ? cur - 8 : 0; tiles = ((cur == 63) ? ~0ull : ((1ull << (cur + 1)) - 1ull)) & ~((1ull << tlo) - 1ull); }
#pragma unroll
        for (int d0 = 0; d0 < 2; ++d0)
#pragma unroll
            for (int r = 0; r < 16; ++r) o[d0][r] = 0.f;
        m = NEG_BIG; l = 0.f;
        u32x4 kr[1];
        if (br == 0) stage_load_k<64>(kr, kc, 256, F.tid);
        attn_dma_loop<0>(F, Kg, pitch, Vg, pitch, tiles, kmax, kmin, rsel, (const LAS u64*)nullptr, qr, o, m, l);
        const float lc = swap_sum(l), invc = 1.0f / fmaxf(lc, 1e-30f), mc = m;
        finalize_rows(l, gate, wsf, r32, hi, rli);
#pragma unroll
        for (int d0 = 0; d0 < 2; ++d0)
#pragma unroll
            for (int r = 0; r < 16; r += 2) oacc[d0][r >> 1] = pkh(h2f(oacc[d0][r >> 1] & 0xffffu) + o[d0][r] * rli[r], h2f(oacc[d0][r >> 1] >> 16) + o[d0][r + 1] * rli[r + 1]);
        if (br == 0) {
            stage_write_k<64>(F.lds + A_KB, kr, F.tid);
            __syncthreads();
            int cb = 0; const int qi = 32 * qs + r32;
            f32x16 negmc;
#pragma unroll
            for (int r = 0; r < 16; ++r) negmc[r] = -mc;
            for (int tl = 0; tl < ntc; ++tl) {
                const bool more = tl + 1 < ntc;
                if (more) stage_load_k<64>(kr, kc + (size_t)(tl + 1) * 64 * 256, 256, F.tid);
                f32x16 p0, p1;
                qk_tile<64>(p0, p1, F.lds + A_KB + cb * 16384, 0, r32, hi, qr, negmc);
                const int dd = ncmp - (64 * tl + 4 * hi);
#pragma unroll
                for (int r = 0; r < 16; ++r) {
                    p0[r] = (dd >= crow(r, 0)) ? __builtin_amdgcn_exp2f(p0[r]) * invc : 0.f;
                    p1[r] = (dd >= crow(r, 0) + 32) ? __builtin_amdgcn_exp2f(p1[r]) * invc : 0.f;
                }
#pragma unroll
                for (int i = 0; i < 4; ++i) {
                    { const float g4 = (p0[4 * i] + p0[4 * i + 1]) + (p0[4 * i + 2] + p0[4 * i + 3]); const int mi = tl * 16 + 2 * i + hi;
                      __hip_atomic_fetch_add(imp + qi * 65 + mi, (unsigned)(g4 * 67108864.0f + 0.5f), __ATOMIC_RELAXED, __HIP_MEMORY_SCOPE_WORKGROUP);
                      if (mi + 1 < 64) __hip_atomic_fetch_add(imp + qi * 65 + mi + 1, (unsigned)(p0[4 * i + 3] * 67108864.0f + 0.5f), __ATOMIC_RELAXED, __HIP_MEMORY_SCOPE_WORKGROUP); }
                    { const float g4 = (p1[4 * i] + p1[4 * i + 1]) + (p1[4 * i + 2] + p1[4 * i + 3]); const int mi = tl * 16 + 8 + 2 * i + hi;
                      __hip_atomic_fetch_add(imp + qi * 65 + mi, (unsigned)(g4 * 67108864.0f + 0.5f), __ATOMIC_RELAXED, __HIP_MEMORY_SCOPE_WORKGROUP);
                      if (mi + 1 < 64) __hip_atomic_fetch_add(imp + qi * 65 + mi + 1, (unsigned)(p1[4 * i + 3] * 67108864.0f + 0.5f), __ATOMIC_RELAXED, __HIP_MEMORY_SCOPE_WORKGROUP); }
                }
                if (more) stage_write_k<64>(F.lds + A_KB + (cb ^ 1) * 16384, kr, F.tid);
                __syncthreads(); cb ^= 1;
            }
            for (int qq = 0; qq < 8; ++qq) {
                const int q = wave * 8 + qq;
                unsigned key = imp[q * 65 + lane];
                if (lane == 0 || lane == cur || lane == cur - 1) key = 0x7fffffffu;
                const bool adm = lane <= cur;
                u64 mk;
                if (cur < 16) mk = __ballot(adm);
                else {
                    unsigned thr = 0u;
                    for (int bit = 30; bit >= 0; --bit) { const unsigned cand = thr | (1u << bit); if (__popcll(__ballot(adm && key >= cand)) >= 16) thr = cand; }
                    const u64 gt = __ballot(adm && key > thr);
                    u64 eq = __ballot(adm && key == thr);
                    int need = 16 - __popcll(gt), c = __popcll(eq);
                    while (c > need) { eq &= ~(1ull << (63 - __clzll(eq))); --c; }
                    mk = gt | eq;
                }
                if (lane == 0) selm[q] = mk;
            }
            __syncthreads();
            mysel = selm[32 * qs + r32];
            uni = wave_or64(selm[lane]);
        }
    }
    GAS u16* Ob = (GAS u16*)O + (size_t)(b * T + t0 + 32 * qs) * DM + 512 + hb * 64 + r32;
#pragma unroll
    for (int r = 0; r < 16; ++r)
#pragma unroll
        for (int d0 = 0; d0 < 2; ++d0) Ob[(size_t)crow(r, hi) * DM + d0 * 32] = (u16)((oacc[d0][r >> 1] >> (16 * (r & 1))) & 0xffffu);
    __syncthreads();
}

__device__ __forceinline__ void diff_unit(const Frame& F, int b, int h, int qb, float lam_val, half8 (&qr)[4], bool first, int qbn) {
    int lane = F.lane; asm volatile("" : "+v"(lane));
    const int wave = F.wave, r32 = lane & 31, hi = lane >> 5;
    const int c = wave >> 2, qs = wave & 3;
    unsigned char* ws = F.ws;
    const u16* Pb = (const u16*)(ws + WS_P) + (size_t)b * T * ODD_N;
    u16* O = (u16*)(ws + WS_O16);
    const int t0 = qb * 128, tq = t0 + 32 * qs + r32;
    LAS float* wsf = (LAS float*)(F.lds + WSCR_OFF + wave * 1024);
    const int NTn = (qbn >= 0) ? 2 * (qbn + 1) : 0;
    if (first) {
#pragma unroll
        for (int d0 = 0; d0 < 4; ++d0) qr[d0] = *(const GAS half8*)(Pb + (size_t)tq * ODD_N + (2 * h + c) * 64 + hi * 8 + d0 * 16);
    }
    f32x16 o[4]; float m = NEG_BIG, l = 0.f, rli[16];
#pragma unroll
    for (int d0 = 0; d0 < 4; ++d0)
#pragma unroll
        for (int r = 0; r < 16; ++r) o[d0][r] = 0.f;
    const int NT = 2 * (qb + 1);
    const u64 tiles = (NT >= 64) ? ~0ull : ((1ull << NT) - 1ull);
    diff_loop_hs(F, Pb + 1024 + 2 * h * 64, Pb + 2048 + h * 128, NT, tq, 8 * c, qr, o, l, first, NTn); (void)m;
    if (NTn) {
        const int tqn = qbn * 128 + 32 * qs + r32;
#pragma unroll
        for (int d0 = 0; d0 < 4; ++d0) qr[d0] = *(const GAS half8*)(Pb + (size_t)tqn * ODD_N + (2 * h + c) * 64 + hi * 8 + d0 * 16);
    }
    finalize_rows(l, 1.0f, wsf, r32, hi, rli);
    LAS unsigned* stg = (LAS unsigned*)(F.lds + 65536 + qs * 16384 + 8192);
    const int sx0 = r32 ^ (hi << 5), sx1 = sx0 ^ 32;
    if (c == 1) {
#pragma unroll
        for (int r = 0; r < 16; ++r) {
            stg[crow(r, hi) * 64 + sx0] = pkh(o[0][r] * rli[r], o[1][r] * rli[r]);
            stg[crow(r, hi) * 64 + sx1] = pkh(o[2][r] * rli[r], o[3][r] * rli[r]); }
    }
    __syncthreads();
    if (c == 0) {
        LAS float* ssb = (LAS float*)(F.lds + 65536 + qs * 16384);
        LAS u16* ost = (LAS u16*)(F.lds + 65536 + qs * 16384 + 8192);
        unsigned sv0[16], sv1[16];
#pragma unroll
        for (int r = 0; r < 16; ++r) { sv0[r] = stg[crow(r, hi) * 64 + sx0]; sv1[r] = stg[crow(r, hi) * 64 + sx1]; }
#pragma unroll
        for (int r = 0; r < 16; ++r) {
            float ss = 0.f;
            const h16x2 p01 = __builtin_bit_cast(h16x2, sv0[r]), p23 = __builtin_bit_cast(h16x2, sv1[r]);
            const float o2[4] = {(float)p01[0], (float)p01[1], (float)p23[0], (float)p23[1]};
#pragma unroll
            for (int d0 = 0; d0 < 4; ++d0) { o[d0][r] = o[d0][r] * rli[r] - lam_val * o2[d0]; ss += o[d0][r] * o[d0][r]; }
            ssb[crow(r, hi) * 36 + r32] = ss;
        }
        asm volatile("s_waitcnt lgkmcnt(0)" ::: "memory");
        { const int row = lane >> 1, half = lane & 1;
          const LAS f32x4* sp_ = (const LAS f32x4*)(ssb + row * 36 + half * 16);
          const f32x4 a0 = sp_[0], a1 = sp_[1], a2 = sp_[2], a3 = sp_[3];
          float tot = ((a0.x + a0.y) + (a0.z + a0.w)) + ((a1.x + a1.y) + (a1.z + a1.w)) + ((a2.x + a2.y) + (a2.z + a2.w)) + ((a3.x + a3.y) + (a3.z + a3.w));
          tot += __shfl_xor(tot, 1);
          const float rs = 1.0f / sqrtf(tot * (1.0f / 128.0f) + 1e-6f);
          if (half == 0) wsf[64 + row] = rs; }
        asm volatile("s_waitcnt lgkmcnt(0)" ::: "memory");
        float sgv[4];
#pragma unroll
        for (int d0 = 0; d0 < 4; ++d0) sgv[d0] = ((const LAS float*)(F.lds + LDSCTL_OFF + 1024))[d0 * 32 + r32];
#pragma unroll
        for (int r = 0; r < 16; ++r) { const float rs = wsf[64 + crow(r, hi)];
#pragma unroll
            for (int d0 = 0; d0 < 4; ++d0) ost[crow(r, hi) * 128 + d0 * 32 + r32] = (u16)(pkh(o[d0][r] * rs * sgv[d0], 0.f) & 0xffffu); }
        flush_stage<128>(ost, O + (size_t)(b * T + t0 + 32 * qs) * DM + h * 128, lane);
    }
    __syncthreads();
}

__device__ __forceinline__ void even_attn_phase(const Frame& F, int layer) {
    unsigned char* ws = F.ws;
    const u16* P = (const u16*)(ws + WS_P); u16* O = (u16*)(ws + WS_O16);
    const u64* MASK = (const u64*)(ws + WS_MASK);
    const u16* KVC = (const u16*)(ws + WS_KVC);
    const int gw = F.bid * 8 + F.wave, NGW = F.G * 8, lane = F.lane;
    LAS float* pbuf = (LAS float*)(F.lds + F.wave * 16384);
    if (F.G == 256) {
        const int xcd = F.bid & 7, jx = F.bid >> 3, b = xcd >> 1, i = (xcd & 1) * 32 + jx;
        dsa_sparse_wave(F, 0, b, i, (F.G > 80) ? 4 : 0, 0, 1);
#if PROBE_VAR >= 0
        __syncthreads();
        if (layer == 0) { for (int k = 0; k < 2; ++k) dsa_probe_unit<PROBE_VAR>(F, b, k ? 127 - i : i); }
#endif
    }
    __syncthreads();
    if (F.G == 256) {
        const int b = (F.bid & 7) >> 1, g = F.bid & 1, i = F.bid >> 3;
#ifndef NO_NSA
        for (int k = 0; k < 2; ++k) nsa_unit(F, b, g, k ? 63 - i : i);
#endif
    }
}

__device__ __forceinline__ void odd_attn_phase(const Frame& F, int layer) {
    const ArgsP ap = F.a; unsigned char* ws = F.ws; const int oi = layer >> 1;
    const u16* P = (const u16*)(ws + WS_P); u16* O = (u16*)(ws + WS_O16);
    const int gw = F.bid * 8 + F.wave, NGW = F.G * 8, lane = F.lane;
    LAS float* pbuf = (LAS float*)(F.lds + F.wave * 16384);
    const float* lam = G(ap->odd_lambda) + (size_t)oi * 4 * 64;
    const float l01 = wave_sum(lam[lane] * lam[64 + lane]), l23 = wave_sum(lam[128 + lane] * lam[192 + lane]);
    const float lambda_init = 0.8f - 0.6f * expf(-0.3f * (float)layer);
    const float lam_val = expf(l01) - expf(l23) + lambda_init;
    const float* sg = G(ap->odd_subln) + (size_t)oi * 128;
    if (F.G == 256) {
        const int bh = (F.bid & 7) * 4 + ((F.bid >> 3) >> 3), s8 = (F.bid >> 3) & 7;
#ifndef NO_DIFF
        if (F.tid < 128) ((LAS float*)(F.lds + LDSCTL_OFF + 1024))[F.tid] = sg[F.tid] * (1.0f - lambda_init);
        __syncthreads();
        half8 qr[4];
        for (int k = 0; k < 4; ++k) { const int qn = (k == 0) ? 15 - s8 : (k == 1) ? 16 + s8 : 31 - s8;
            diff_unit(F, bh >> 3, bh & 7, (k == 0) ? s8 : (k == 1) ? 15 - s8 : (k == 2) ? 16 + s8 : 31 - s8, lam_val, qr, k == 0, (k < 3) ? qn : -1); }
#endif
    }
}

__device__ __forceinline__ void final_phase(const Frame& F) {
    const ArgsP ap = F.a; const float* psum = (const float*)(F.ws + WS_PSUM);
    const int gw = F.bid * 8 + F.wave, NGW = F.G * 8;
    for (int row = gw; row < M; row += NGW) {
        const float rs = pg8::rowscale(psum, row);
        f32x4* orow = (f32x4*)(G(ap->out) + (size_t)row * DM) + F.lane;
        const f32x4* gg = (const f32x4*)G(ap->final_g) + F.lane;
#pragma unroll
        for (int j = 0; j < 4; ++j) { f32x4 v = orow[64 * j]; const f32x4 g = gg[64 * j]; v = v * rs * g; orow[64 * j] = v; }
    }
}

__global__ void __launch_bounds__(512, 2) trunk_fwd(Args args) {
    extern __shared__ __attribute__((aligned(16))) unsigned char lds_raw[];
    Frame F;
    F.lds = (LAS unsigned char*)lds_raw; F.tid = threadIdx.x; F.lane = F.tid & 63; F.wave = __builtin_amdgcn_readfirstlane(F.tid >> 6);
    F.G = gridDim.x; F.bid = blockIdx.x; F.a = kargs(); F.ws = G(F.a->ws);
    unsigned char* ws = F.ws;
    const int ph_lo = F.a->ph_lo, ph_hi = F.a->ph_hi;
    for (int u = F.tid; u < (LDS_BYTES - LDSCTL_OFF) / 4; u += 512) ((LAS unsigned*)(F.lds + LDSCTL_OFF))[u] = 0u;
    __syncthreads();
    const bool multi = (ph_hi - ph_lo) > 1;
    const int wave_s = F.wave;
    XcdBarrier bar; bar.bar = (unsigned*)(ws + WS_CTL) + CW_BAR; bar.x = 0; bar.st = nullptr;
    if (multi) bar = xcd_barrier_post((unsigned*)(ws + WS_CTL) + CW_BAR, (volatile LAS unsigned*)(F.lds + MISC_OFF));

    const float* psum = nullptr;
#ifndef DUP_KIND
#define DUP_KIND -1
#endif
#ifndef DUP_PAR
#define DUP_PAR -1
#endif
    int dup_done = 0;
    for (int ph = ph_lo; ph < ph_hi; ++ph) {
        int layer, kind; phase_decode(ph, layer, kind);
        if (DUP_KIND >= 0 && kind == DUP_KIND && (DUP_PAR < 0 || (layer & 1) == DUP_PAR) && !dup_done) { dup_done = 1; --ph; }
        else dup_done = 0;
        F.a = kargs();
        { unsigned char* w_ = F.a->ws; int g_ = gridDim.x, b_ = blockIdx.x; asm volatile("" : "+s"(w_), "+s"(g_), "+s"(b_)); w_ = G(w_); ws = w_; F.ws = w_; F.G = g_; F.bid = b_; psum = (const float*)(w_ + WS_PSUM); }
        { int w_ = wave_s, z_ = 0; asm volatile("" : "+s"(w_), "+v"(z_)); int tid_ = w_ * 64 + (int)__builtin_amdgcn_mbcnt_hi(~0u, __builtin_amdgcn_mbcnt_lo(~0u, (unsigned)z_)); asm volatile("" : "+v"(tid_));     F.tid = tid_; F.lane = tid_ & 63; F.wave = __builtin_amdgcn_readfirstlane(tid_ >> 6); }
        const bool odd = (layer & 1) != 0;
#ifndef NO_PREP
        if (kind == K_PREP) {} else
#endif
        if (0) {}
#ifndef NO_INPROJ
        else if (kind == K_INPROJ) {
            const int N = odd ? ODD_N : EVEN_N, NG = odd ? ODD_N : 2048;
            pg8::Gemm g{(const u16*)(ws + WS_X16), (const u16*)(ws + WS_WIN + (odd ? WS_ALT : (size_t)0)), M, NG, DM};
            pg8::StaticOrder S; S.init(M, NG, F.G, F.bid);
            const u64 rope_even = 0xFFull | (1ull << 8) | (0xFull << 10) | (1ull << 14) | (0xFFull << 15) | (3ull << 23) | (3ull << 27) | (1ull << 32) | (1ull << 35);
            const u64 scale_even = 0xFFull | (0xFFull << 15);
            const u64 rope_odd = 0xFFFFFFFFull, scale_odd = 0xFFFFull;
            pg8::EpiProj E{(u16*)(ws + WS_P), N, psum, (const float*)(ws + WS_COS), (const float*)(ws + WS_SIN), odd ? rope_odd : rope_even, odd ? scale_odd : scale_even, odd ? (u16*)nullptr : (u16*)(ws + WS_KIF)};
            pg8::gemm_phase<pg8::EpiProj, pg8::StaticOrder, true, true>(F.lds, F.tid, g, S, E);
        }
#endif
#ifndef NO_PRE
        else if (kind == K_PRE) pre_phase(F, layer);
#endif
#ifndef NO_CMP
        else if (kind == K_CMP1) {
            pg8::Gemm g{(const u16*)(ws + WS_AC), (const u16*)(ws + WS_WC1), 4096, 512, 2048};
            int one_ = 1; asm volatile("" : "+s"(one_)); pg8::DiagOrder S{F.bid, one_}; pg8::EpiCmp<1> E{(u16*)(ws + WS_HC)};
            pg8::gemm_phase<pg8::EpiCmp<1>, pg8::DiagOrder, true, true>(F.lds, F.tid, g, S, E);
            pg8::Gemm g2{(const u16*)(ws + WS_X16), (const u16*)(ws + WS_WIN), M, EVEN_N, DM};
            pg8::TailOrder S2{F.bid, one_};
            const u64 rope_even = 0xFFull | (1ull << 8) | (0xFull << 10) | (1ull << 14) | (0xFFull << 15) | (3ull << 23) | (3ull << 27) | (1ull << 32) | (1ull << 35);
            pg8::EpiProj E2{(u16*)(ws + WS_P), EVEN_N, psum, (const float*)(ws + WS_COS), (const float*)(ws + WS_SIN), rope_even, 0xFFull | (0xFFull << 15), (u16*)nullptr};
            pg8::gemm_phase<pg8::EpiProj, pg8::TailOrder, true, true>(F.lds, F.tid, g2, S2, E2);
            if (F.G > 80 && F.bid >= 80) dsa_sparse_wave(F, 1, 0, 0, 0, (F.bid - 80) * 8 + F.wave, (F.G - 80) * 8);
            if (F.bid < 16) {
                asm volatile("s_waitcnt vmcnt(0)" ::: "memory"); __syncthreads();
                if (F.tid == 0) { __builtin_amdgcn_fence(__ATOMIC_ACQUIRE, "agent"); asm volatile("s_waitcnt vmcnt(0)" ::: "memory"); }
                __syncthreads();
                int k256_ = 256; asm volatile("" : "+s"(k256_));
                pg8::Gemm g3{(const u16*)(ws + WS_HC), (const u16*)(ws + WS_WC2), 4096, 512, k256_};
                pg8::DiagOrder S3{F.bid, one_}; pg8::EpiCmp<0> E3{(u16*)(ws + WS_KVC)};
                pg8::gemm_phase<pg8::EpiCmp<0>, pg8::DiagOrder, true, true>(F.lds, F.tid, g3, S3, E3);
            }
        }
#endif
#ifndef NO_ATTN
        else if (kind == K_ATTN) { if (odd) odd_attn_phase(F, layer); else even_attn_phase(F, layer); }
#endif
#ifndef NO_OUT
        else if (kind == K_OUTPROJ) {
            pg8::Gemm g{(const u16*)(ws + WS_O16), (const u16*)(ws + WS_WOUT + (odd ? WS_ALT : (size_t)0)), M, DM, DM};
            pg8::StaticOrder S; S.init(M, DM, F.G, F.bid);
            pg8::EpiResid E{(const u16*)(ws + WS_X16), (float*)nullptr, (u16*)(ws + WS_X16), (float*)(ws + WS_PSUM)};
            pg8::gemm_phase<pg8::EpiResid, pg8::StaticOrder, true, true>(F.lds, F.tid, g, S, E);
        }
#endif
#ifndef NO_UP
        else if (kind == K_UP) {
            pg8::Gemm g{(const u16*)(ws + WS_X16), (const u16*)(ws + WS_WUP + (odd ? WS_ALT : (size_t)0)), M, DFF, DM};
            pg8::StaticOrder S; S.init(M, DFF, F.G, F.bid);
            pg8::EpiUp E{(u16*)(ws + WS_U), DFF, psum};
            pg8::gemm_phase<pg8::EpiUp, pg8::StaticOrder, true, true>(F.lds, F.tid, g, S, E);
        }
#endif
#ifndef NO_DOWN
        else if (kind == K_DOWN) {
            pg8::Gemm g{(const u16*)(ws + WS_U), (const u16*)(ws + WS_WDN + (odd ? WS_ALT : (size_t)0)), M, DM, DFF};
            pg8::StaticOrder S; S.init(M, DM, F.G, F.bid);
            pg8::EpiResid E{(const u16*)(ws + WS_X16), (layer == 3) ? G(F.a->out) : (float*)nullptr, (u16*)(ws + WS_X16), (float*)(ws + WS_PSUM)};
            pg8::gemm_phase<pg8::EpiResid, pg8::StaticOrder, true, true>(F.lds, F.tid, g, S, E);
        }
#endif
        else final_phase(F);
#ifndef NO_PREP
        if (kind == K_PREP || (kind == K_DOWN && layer < 3)) prep_phase(F, (kind == K_PREP) ? layer : layer + 1);
#endif
        if (ph + 1 < ph_hi || dup_done) xcd_barrier(bar);
    }
}

extern "C" void kernel_launch(void* const* d_in, const int* in_sizes, int n_in, void* d_out, int out_size, void* d_ws, size_t ws_size, hipStream_t stream) {
    static int grid = 0;
    if (grid == 0) {
        if (n_in != 15 || out_size != M * DM || ws_size < WS_END) { fprintf(stderr, "kernel_launch: unexpected shapes (n_in %d out %d ws %zu)\n", n_in, out_size, ws_size); grid = -1; return; }
        int dev = 0, cus = 0;
        if (hipGetDevice(&dev) != hipSuccess || hipDeviceGetAttribute(&cus, hipDeviceAttributeMultiprocessorCount, dev) != hipSuccess) { grid = -1; return; }
        if (hipFuncSetAttribute((const void*)trunk_fwd, hipFuncAttributeMaxDynamicSharedMemorySize, LDS_BYTES) != hipSuccess) { fprintf(stderr, "kernel_launch: hipFuncSetAttribute failed\n"); grid = -1; return; }
        int per_cu = 0;
        if (hipOccupancyMaxActiveBlocksPerMultiprocessor(&per_cu, (const void*)trunk_fwd, 512, LDS_BYTES) != hipSuccess || per_cu < 1) { fprintf(stderr, "kernel_launch: occupancy query says %d\n", per_cu); }
        (void)hipGetLastError();
        grid = cus;
    }
    if (grid < 0) return;
    (void)hipMemsetAsync((char*)d_ws + WS_CTL, 0, CTL_ZERO_BYTES, stream);
    Args a{};
    a.x = (const float*)d_in[0]; a.mix_g = (const float*)d_in[1]; a.mlp_g = (const float*)d_in[2]; a.even_w_in = (const float*)d_in[3]; a.even_pe = (const float*)d_in[4];
    a.even_w1 = (const float*)d_in[5]; a.even_w2 = (const float*)d_in[6]; a.even_w_out = (const float*)d_in[7]; a.odd_w_in = (const float*)d_in[8]; a.odd_lambda = (const float*)d_in[9];
    a.odd_subln = (const float*)d_in[10]; a.odd_w_out = (const float*)d_in[11]; a.mlp_up = (const float*)d_in[12]; a.mlp_down = (const float*)d_in[13]; a.final_g = (const float*)d_in[14];
    a.out = (float*)d_out; a.ws = (unsigned char*)d_ws;
#if MK_ONE_LAUNCH
    a.ph_lo = 0; a.ph_hi = NPHASE;
    hipLaunchKernelGGL(trunk_fwd, dim3(grid), dim3(512), LDS_BYTES, stream, a);
#else
    for (int ph = 0; ph < NPHASE; ++ph) { a.ph_lo = ph; a.ph_hi = ph + 1; hipLaunchKernelGGL(trunk_fwd, dim3(grid), dim3(512), LDS_BYTES, stream, a); }
#endif
}
```
